# Optimizing an MI355X kernel written in HIP

```python
import math
import jax, jax.numpy as jnp
from jax import lax
import numpy as np

D_MODEL = 2048
BATCH = 4
SEQ = 8192
DEPTH = 1

CHUNK = 64
Q_BLOCK = 128
ATT_HEADS = 4
ATT_HEAD_DIM = 128
ATT_V_DIM = 2 * ATT_HEAD_DIM
ATT_WIDTH = ATT_HEADS * ATT_V_DIM
ROPE_THETA = 10000.0
CONV_CH = D_MODEL - ATT_WIDTH
CONV_WIDTH = 31
QK_COLS = ATT_HEADS * 2 * ATT_HEAD_DIM
IN_COLS = 2 * QK_COLS + ATT_WIDTH + 2 * CONV_CH
MIX_WIDTH = ATT_WIDTH + CONV_CH
FFN_HIDDEN = int(math.ceil(8 * D_MODEL / 3 / 256) * 256)
EPS = 1e-6
LN_EPS = 1e-5

kernel_name = "hybrid_diffattn_conformerconv_block"


def rms_norm(x, g, eps=EPS):
    xf = x.astype(jnp.float32)
    y = xf * lax.rsqrt(jnp.mean(xf * xf, axis=-1, keepdims=True) + eps)
    return (y * g.astype(jnp.float32)).astype(x.dtype)


def layer_norm(x, g, b, eps=LN_EPS):
    xf = x.astype(jnp.float32)
    mu = jnp.mean(xf, axis=-1, keepdims=True)
    var = jnp.mean(jnp.square(xf - mu), axis=-1, keepdims=True)
    y = (xf - mu) * lax.rsqrt(var + eps)
    return (y * g.astype(jnp.float32) + b.astype(jnp.float32)).astype(x.dtype)


def rope_tables(seq, dim):
    inv_freq = ROPE_THETA ** (-jnp.arange(0, dim, 2, dtype=jnp.float32) / dim)
    ang = jnp.arange(seq, dtype=jnp.float32)[:, None] * inv_freq[None, :]
    ang = jnp.concatenate([ang, ang], axis=-1)
    return jnp.cos(ang), jnp.sin(ang)


def apply_rope(t, cos, sin):
    half = t.shape[-1] // 2
    t1, t2 = t[..., :half], t[..., half:]
    rot = jnp.concatenate([-t2, t1], axis=-1)
    c = cos[None, :, None, None, :].astype(t.dtype)
    s = sin[None, :, None, None, :].astype(t.dtype)
    return t * c + rot * s


def diff_attention(q, k, v, lam):
    B, S, H, _, d = q.shape
    E = v.shape[-1]
    nb = S // Q_BLOCK
    scale = 1.0 / math.sqrt(d)
    qb = q.reshape(B, nb, Q_BLOCK, H, 2, d).transpose(1, 0, 2, 3, 4, 5)
    key_chunk = jnp.arange(S) // CHUNK

    def one_block(args):
        q_blk, i = args
        q_chunk = (i * Q_BLOCK + jnp.arange(Q_BLOCK)) // CHUNK
        s = jnp.einsum('bqhcd,bkhcd->bhcqk', q_blk, k).astype(jnp.float32) * scale
        mask = key_chunk[None, :] <= q_chunk[:, None]
        s = jnp.where(mask[None, None, None], s, -jnp.inf)
        p = jax.nn.softmax(s, axis=-1)
        w = p[:, :, 0] - lam * p[:, :, 1]
        return jnp.einsum('bhqk,bkhe->bqhe', w.astype(v.dtype), v)

    out = lax.map(one_block, (qb, jnp.arange(nb)))
    return out.transpose(1, 0, 2, 3, 4).reshape(B, S, H, E)


def causal_depthwise_conv(u, w, b):
    y = lax.conv_general_dilated(
        u, w.astype(u.dtype), window_strides=(1,), padding=[(CONV_WIDTH - 1, 0)],
        dimension_numbers=('NWC', 'WIO', 'NWC'), feature_group_count=u.shape[-1])
    return y + b.astype(u.dtype)


def setup_inputs(seed: int = 0) -> dict:
    key = jax.random.key(seed)
    ks = jax.random.split(key, 20)
    f32 = jnp.float32
    L = DEPTH
    d = ATT_HEAD_DIM
    nrm = lambda k, shape, s: jax.random.normal(k, shape, f32) * s
    return {
        "x": jax.random.normal(ks[0], (BATCH, SEQ, D_MODEL), f32),
        "norm1_g": 1.0 + nrm(ks[1], (L, D_MODEL), 0.02),
        "w_in": nrm(ks[2], (L, D_MODEL, IN_COLS), D_MODEL ** -0.5),
        "q_norm_g": 1.0 + nrm(ks[3], (L, d), 0.02),
        "k_norm_g": 1.0 + nrm(ks[4], (L, d), 0.02),
        "lambda_q1": nrm(ks[5], (L, d), 0.1),
        "lambda_k1": nrm(ks[6], (L, d), 0.1),
        "lambda_q2": nrm(ks[7], (L, d), 0.1),
        "lambda_k2": nrm(ks[8], (L, d), 0.1),
        "subln_g": 1.0 + nrm(ks[9], (L, ATT_V_DIM), 0.02),
        "conv_w": nrm(ks[10], (L, CONV_WIDTH, 1, CONV_CH), CONV_WIDTH ** -0.5),
        "conv_b": nrm(ks[11], (L, CONV_CH), 0.02),
        "conv_ln_g": 1.0 + nrm(ks[12], (L, CONV_CH), 0.02),
        "conv_ln_b": nrm(ks[13], (L, CONV_CH), 0.02),
        "w_out": nrm(ks[14], (L, MIX_WIDTH, D_MODEL), MIX_WIDTH ** -0.5),
        "norm2_g": 1.0 + nrm(ks[15], (L, D_MODEL), 0.02),
        "w_gate": nrm(ks[16], (L, D_MODEL, FFN_HIDDEN), D_MODEL ** -0.5),
        "w_up": nrm(ks[17], (L, D_MODEL, FFN_HIDDEN), D_MODEL ** -0.5),
        "w_down": nrm(ks[18], (L, FFN_HIDDEN, D_MODEL), FFN_HIDDEN ** -0.5),
    }


def reference(x, norm1_g, w_in, q_norm_g, k_norm_g, lambda_q1, lambda_k1,
              lambda_q2, lambda_k2, subln_g, conv_w, conv_b, conv_ln_g,
              conv_ln_b, w_out, norm2_g, w_gate, w_up, w_down):
    B, S, D = x.shape
    H, d = ATT_HEADS, ATT_HEAD_DIM
    cos, sin = rope_tables(S, d)
    h = x
    for l in range(DEPTH):
        lambda_init = 0.8 - 0.6 * math.exp(-0.3 * l)
        xn = rms_norm(h, norm1_g[l])
        proj = jnp.einsum('bsd,dn->bsn', xn, w_in[l].astype(xn.dtype))
        q, k, v, ga, gg = jnp.split(
            proj, np.cumsum([QK_COLS, QK_COLS, ATT_WIDTH, CONV_CH]).tolist(), axis=-1)
        q = q.reshape(B, S, H, 2, d)
        k = k.reshape(B, S, H, 2, d)
        v = v.reshape(B, S, H, ATT_V_DIM)
        q = apply_rope(rms_norm(q, q_norm_g[l]), cos, sin)
        k = apply_rope(rms_norm(k, k_norm_g[l]), cos, sin)
        lam = (jnp.exp(jnp.sum(lambda_q1[l].astype(jnp.float32) * lambda_k1[l].astype(jnp.float32)))
               - jnp.exp(jnp.sum(lambda_q2[l].astype(jnp.float32) * lambda_k2[l].astype(jnp.float32)))
               + lambda_init)
        att = diff_attention(q, k, v, lam)
        att = rms_norm(att, subln_g[l]) * (1.0 - lambda_init)
        att = att.reshape(B, S, ATT_WIDTH)
        u = ga * jax.nn.sigmoid(gg)
        u = causal_depthwise_conv(u, conv_w[l], conv_b[l])
        u = jax.nn.silu(layer_norm(u, conv_ln_g[l], conv_ln_b[l]))
        mixed = jnp.concatenate([att, u], axis=-1)
        h = h + jnp.einsum('bsm,md->bsd', mixed, w_out[l].astype(mixed.dtype))
        hn = rms_norm(h, norm2_g[l])
        a = jnp.einsum('bsd,df->bsf', hn, w_gate[l].astype(hn.dtype))
        bu = jnp.einsum('bsd,df->bsf', hn, w_up[l].astype(hn.dtype))
        h = h + jnp.einsum('bsf,fd->bsd', jax.nn.silu(a) * bu, w_down[l].astype(hn.dtype))
    return h
```

```cpp
#include <hip/hip_runtime.h>
#include <hip/hip_cooperative_groups.h>
#include <cstdio>
#include <cstdint>
namespace pg8 {
#define PG8_LAS __attribute__((address_space(3)))
typedef unsigned short bf16_t;
typedef short bf16x8 __attribute__((ext_vector_type(8)));
typedef float f32x4 __attribute__((ext_vector_type(4)));
typedef unsigned u32x4 __attribute__((ext_vector_type(4)));
constexpr int BM = 256, BK = 64, HALF = 128, HTB = HALF * BK * 2  , STAGE_BYTES = 8 * HTB, NXCD = 8, WGM = 8;

__host__ __device__ __forceinline__ int lds_byte(int r, int c) { const int st = (r >> 4) * 2 + (c >> 5), rr = r & 15, cc = c & 31, ob = rr * 64 + cc * 2; return st * 1024 + (ob ^ (((ob >> 9) & 1) << 5)); }
__host__ __device__ __forceinline__ void stage_rc(int b, int& R, int& C) { const int st = b / 1024, sb = b % 1024, swz = sb ^ (((sb >> 9) & 1) << 5); R = (st >> 1) * 16 + swz / 64; C = (st & 1) * 32 + (swz % 64) / 2; }
__host__ __device__ __forceinline__ int perm32(int rho) { const int n = rho >> 4, i = rho & 15; return 8 * (i >> 2) + 4 * n + (i & 3); }

struct Unit { int pm, pn; };
struct Gemm { const bf16_t* A; const bf16_t* Bt; int M, N, K; };

struct StaticOrder {
    int nM, nN, nwg, G, c, rep;
    __host__ __device__ void init(int M, int N, int G_, int c_) { nM = M / BM; nN = N / BM; nwg = nM * nN; G = G_; c = c_; rep = 1; }
    __host__ __device__ bool next(int i, Unit& u) const {
        if (rep > 1) { const int cnt = (nwg - c + G - 1) / G; if (i >= cnt * rep) return false; i = i % cnt; }
        const long L = (long)i * G + c; if (L >= nwg) return false;
        int wgid = (int)L; { const int q = nwg / NXCD, r = nwg % NXCD, xcd = wgid % NXCD, off = wgid / NXCD; wgid = (xcd < r ? xcd * (q + 1) : r * (q + 1) + (xcd - r) * q) + off; }
        const int nig = WGM * nN, gid = wgid / nig, fm = gid * WGM, gsz = (nM - fm) < WGM ? (nM - fm) : WGM;
        u.pm = fm + ((wgid % nig) % gsz); u.pn = (wgid % nig) / gsz; return true;
    }
    __device__ __forceinline__ void a_ready(const Unit&) const {}
    __device__ __forceinline__ void done(const Unit&) const {}
};

__device__ __forceinline__ unsigned cvt_pk_bf16(float lo, float hi) { unsigned r; asm volatile("v_cvt_pk_bf16_f32 %0, %1, %2" : "=v"(r) : "v"(lo), "v"(hi)); return r; }
typedef float f32x2 __attribute__((ext_vector_type(2)));
__device__ __forceinline__ float sigmoid_fast(float x) { return __builtin_amdgcn_rcpf(1.0f + __builtin_amdgcn_exp2f(-1.4426950408889634f * x)); }
__device__ __forceinline__ u32x4 pack8(const f32x4 v0, const f32x4 v1) { u32x4 w; w.x = cvt_pk_bf16(v0[0], v0[1]); w.y = cvt_pk_bf16(v0[2], v0[3]); w.z = cvt_pk_bf16(v1[0], v1[1]); w.w = cvt_pk_bf16(v1[2], v1[3]); return w; }

struct EpiProj {
    static constexpr bool PERM = true, AFTER_DRAIN = false;
    bf16_t *Q, *K, *U;
    __device__ __forceinline__ void operator()(const f32x4 (&acc)[2][2][4][2], const Unit& u, int wr, int wc, int fr, int fq) const {
        const int row0 = u.pm * BM + wr * 64 + fr;
        if (u.pn < 8) {
            bf16_t* base = (u.pn < 4 ? Q : K) + (u.pn & 3) * 256 + wc * 32 + 8 * fq;
#pragma unroll
            for (int ai = 0; ai < 2; ++ai)
#pragma unroll
                for (int m = 0; m < 4; ++m) { bf16_t* rowp = base + (size_t)(row0 + ai * HALF + m * 16) * 1024;
#pragma unroll
                    for (int bj = 0; bj < 2; ++bj) *(u32x4*)(rowp + bj * HALF) = pack8(acc[ai][bj][m][0], acc[ai][bj][m][1]); }
        } else {
            bf16_t* base = U + (u.pn - 8) * 128 + wc * 32 + 8 * fq;
#pragma unroll
            for (int ai = 0; ai < 2; ++ai)
#pragma unroll
                for (int m = 0; m < 4; ++m) { bf16_t* rowp = base + (size_t)(row0 + ai * HALF + m * 16) * 1024;
                    f32x4 v[2];
#pragma unroll
                    for (int n = 0; n < 2; ++n) { const f32x4 a = acc[ai][0][m][n], g = acc[ai][1][m][n];
                        v[n] = (f32x4){a[0] * sigmoid_fast(g[0]), a[1] * sigmoid_fast(g[1]), a[2] * sigmoid_fast(g[2]), a[3] * sigmoid_fast(g[3])}; }
                    *(u32x4*)rowp = pack8(v[0], v[1]); }
        }
    }
};
struct EpiPlain {
    static constexpr bool PERM = true, AFTER_DRAIN = false;
    bf16_t* O; int ldc;
    __device__ __forceinline__ void operator()(const f32x4 (&acc)[2][2][4][2], const Unit& u, int wr, int wc, int fr, int fq) const {
        const int row0 = u.pm * BM + wr * 64 + fr; bf16_t* base = O + u.pn * BM + wc * 32 + 8 * fq;
#pragma unroll
        for (int ai = 0; ai < 2; ++ai)
#pragma unroll
            for (int m = 0; m < 4; ++m) { bf16_t* rowp = base + (size_t)(row0 + ai * HALF + m * 16) * ldc;
#pragma unroll
                for (int bj = 0; bj < 2; ++bj) *(u32x4*)(rowp + bj * HALF) = pack8(acc[ai][bj][m][0], acc[ai][bj][m][1]); }
    }
};
struct EpiSwiGLU {
    static constexpr bool PERM = true, AFTER_DRAIN = false;
    bf16_t* O; int ldc;
    __device__ __forceinline__ void operator()(const f32x4 (&acc)[2][2][4][2], const Unit& u, int wr, int wc, int fr, int fq) const {
        const int row0 = u.pm * BM + wr * 64 + fr; bf16_t* base = O + u.pn * 128 + wc * 32 + 8 * fq;
#pragma unroll
        for (int ai = 0; ai < 2; ++ai)
#pragma unroll
            for (int m = 0; m < 4; ++m) { bf16_t* rowp = base + (size_t)(row0 + ai * HALF + m * 16) * ldc;
                f32x4 v[2];
#pragma unroll
                for (int n = 0; n < 2; ++n) { const f32x4 a = acc[ai][0][m][n], b = acc[ai][1][m][n];
                    v[n] = (f32x4){a[0] * sigmoid_fast(a[0]) * b[0], a[1] * sigmoid_fast(a[1]) * b[1], a[2] * sigmoid_fast(a[2]) * b[2], a[3] * sigmoid_fast(a[3]) * b[3]}; }
                *(u32x4*)rowp = pack8(v[0], v[1]); }
    }
};
struct EpiSwiGLUN {
    static constexpr bool PERM = true, AFTER_DRAIN = false;
    bf16_t* O; int ldc; const float* rss;
    __device__ __forceinline__ void operator()(const f32x4 (&acc)[2][2][4][2], const Unit& u, int wr, int wc, int fr, int fq) const {
        const int row0 = u.pm * BM + wr * 64 + fr; bf16_t* base = O + u.pn * 128 + wc * 32 + 8 * fq;
#pragma unroll
        for (int ai = 0; ai < 2; ++ai)
#pragma unroll
            for (int m = 0; m < 4; ++m) { const int row = row0 + ai * HALF + m * 16; bf16_t* rowp = base + (size_t)row * ldc;
                const f32x4 p0 = *(const f32x4*)(rss + (size_t)row * 8), p1 = *(const f32x4*)(rss + (size_t)row * 8 + 4);
                const float rs = 1.0f / sqrtf((((p0[0] + p0[1]) + (p0[2] + p0[3])) + ((p1[0] + p1[1]) + (p1[2] + p1[3]))) * (1.0f / 2048.0f) + 1e-6f);
                f32x4 v[2];
#pragma unroll
                for (int n = 0; n < 2; ++n) { const f32x4 a = acc[ai][0][m][n] * rs, b = acc[ai][1][m][n] * rs;
                    v[n] = (f32x4){a[0] * sigmoid_fast(a[0]) * b[0], a[1] * sigmoid_fast(a[1]) * b[1], a[2] * sigmoid_fast(a[2]) * b[2], a[3] * sigmoid_fast(a[3]) * b[3]}; }
                *(u32x4*)rowp = pack8(v[0], v[1]); }
    }
};
struct EpiSwiGLUR {
    static constexpr bool PERM = true, AFTER_DRAIN = false;
    bf16_t* O; int ldc; const float* rsv;
    __device__ __forceinline__ void operator()(const f32x4 (&acc)[2][2][4][2], const Unit& u, int wr, int wc, int fr, int fq) const {
        const int row0 = u.pm * BM + wr * 64 + fr; bf16_t* base = O + u.pn * 128 + wc * 32 + 8 * fq;
        float rs8[8];
#pragma unroll
        for (int i = 0; i < 8; ++i) rs8[i] = rsv[row0 + (i >> 2) * HALF + (i & 3) * 16];
#pragma unroll
        for (int ai = 0; ai < 2; ++ai)
#pragma unroll
            for (int m = 0; m < 4; ++m) { const int row = row0 + ai * HALF + m * 16; bf16_t* rowp = base + (size_t)row * ldc; const float rs = rs8[ai * 4 + m];
                f32x4 v[2];
#pragma unroll
                for (int n = 0; n < 2; ++n) { const f32x4 a = acc[ai][0][m][n] * rs, b = acc[ai][1][m][n] * rs;
                    v[n] = (f32x4){a[0] * sigmoid_fast(a[0]) * b[0], a[1] * sigmoid_fast(a[1]) * b[1], a[2] * sigmoid_fast(a[2]) * b[2], a[3] * sigmoid_fast(a[3]) * b[3]}; }
                *(u32x4*)rowp = pack8(v[0], v[1]); }
    }
};
struct EpiResNorm {
    static constexpr bool PERM = false, AFTER_DRAIN = false;
    const float* base; float* out; bf16_t* hb; float* rss; int ldc; PG8_LAS float* red;
    __device__ __forceinline__ void operator()(const f32x4 (&acc)[2][2][4][2], const Unit& u, int wr, int wc, int fr, int fq) const {
        const int row0 = u.pm * BM + wr * 64 + fr, col0 = u.pn * BM + wc * 32 + 4 * fq;
#pragma unroll
        for (int ai = 0; ai < 2; ++ai)
#pragma unroll
            for (int m = 0; m < 4; ++m) { const int row = row0 + ai * HALF + m * 16; const size_t off = (size_t)row * ldc + col0; float ss = 0.f;
#pragma unroll
                for (int bj = 0; bj < 2; ++bj)
#pragma unroll
                    for (int n = 0; n < 2; ++n) { const f32x4 h = *(const f32x4*)(base + off + bj * HALF + n * 16) + acc[ai][bj][m][n];
                        *(f32x4*)(out + off + bj * HALF + n * 16) = h; ss += (h[0] * h[0] + h[1] * h[1]) + (h[2] * h[2] + h[3] * h[3]);
                        unsigned long long w = (unsigned long long)cvt_pk_bf16(h[0], h[1]) | ((unsigned long long)cvt_pk_bf16(h[2], h[3]) << 32);
                        *(unsigned long long*)(hb + off + bj * HALF + n * 16) = w; }
                ss += __shfl_xor(ss, 16); ss += __shfl_xor(ss, 32);
                if (fq == 0) red[(ai * HALF + wr * 64 + m * 16 + fr) * 4 + wc] = ss; }
        asm volatile("s_waitcnt lgkmcnt(0)" ::: "memory"); __builtin_amdgcn_s_barrier(); asm volatile("" ::: "memory");
        { const int t = threadIdx.x; if (t < 256) { const f32x4 p = *(const PG8_LAS f32x4*)(red + t * 4); rss[(size_t)(u.pm * BM + t) * 8 + u.pn] = (p[0] + p[1]) + (p[2] + p[3]); } }
        asm volatile("s_waitcnt lgkmcnt(0)" ::: "memory"); __builtin_amdgcn_s_barrier(); asm volatile("" ::: "memory");
    }
};
struct EpiRes {
    static constexpr bool PERM = false, AFTER_DRAIN = false;
    const float* base; float* out; int ldc;
    __device__ __forceinline__ void operator()(const f32x4 (&acc)[2][2][4][2], const Unit& u, int wr, int wc, int fr, int fq) const {
        const int row0 = u.pm * BM + wr * 64 + fr, col0 = u.pn * BM + wc * 32 + 4 * fq;
#pragma unroll
        for (int ai = 0; ai < 2; ++ai)
#pragma unroll
            for (int m = 0; m < 4; ++m) { const size_t off = (size_t)(row0 + ai * HALF + m * 16) * ldc + col0;
#pragma unroll
                for (int bj = 0; bj < 2; ++bj)
#pragma unroll
                    for (int n = 0; n < 2; ++n) { const f32x4 b = *(const f32x4*)(base + off + bj * HALF + n * 16); *(f32x4*)(out + off + bj * HALF + n * 16) = b + acc[ai][bj][m][n]; } }
    }
};
template <class Epi, class Sched, bool ALIGN_EPI = false, bool SP2 = false>
__device__ __forceinline__ void gemm_phase(PG8_LAS unsigned char* lds, const Gemm g, const Sched& S, const Epi& E) {
    const int tid = threadIdx.x, wid = __builtin_amdgcn_readfirstlane(tid >> 6), lane = tid & 63, wr = wid >> 2, wc = wid & 3, fr = lane & 15, fq = lane >> 4;
    const int K = g.K, nt = K / BK;
    unsigned voffA[2], voffB[2];
#pragma unroll
    for (int i = 0; i < 2; ++i) { int R, C; stage_rc(tid * 16 + i * 8192, R, C); const int Rb = Epi::PERM ? ((R & ~31) + perm32(R & 31)) : R;
        voffA[i] = (unsigned)(R * K + C) * 2u; voffB[i] = (unsigned)(Rb * K + C) * 2u; }
    const size_t kstep = (size_t)(BK * 2);
    const size_t hstep = (size_t)HALF * K * 2;
    const size_t tstep = 2 * hstep;
    const unsigned ldsw = (unsigned)wid * 1024u;
    const int aoff = lds_byte(wr * 64 + fr, fq * 8), boff = lds_byte(wc * 32 + fr, fq * 8);
#define PG8_SA(b, h) (((b) * 2 + (h)) * HTB)
#define PG8_SB(b, h) ((4 + (b) * 2 + (h)) * HTB)
#define PG8_STAGE(bufoff, gbase, voff) do { _Pragma("unroll") for (int _i = 0; _i < 2; ++_i) \
        __builtin_amdgcn_global_load_lds((const unsigned*)((const char*)(gbase) + (voff)[_i]), (PG8_LAS unsigned*)(lds + (bufoff) + ldsw + _i * 8192), 16, 0, 0); } while (0)
#define PG8_LDA(dst, b, h) do { _Pragma("unroll") for (int m = 0; m < 4; ++m) _Pragma("unroll") for (int k = 0; k < 2; ++k) dst[m][k] = *(const PG8_LAS bf16x8*)(lds + PG8_SA(b, h) + aoff + m * 2048 + k * 1024); } while (0)
#define PG8_LDB(dst, b, h) do { _Pragma("unroll") for (int n = 0; n < 2; ++n) _Pragma("unroll") for (int k = 0; k < 2; ++k) dst[n][k] = *(const PG8_LAS bf16x8*)(lds + PG8_SB(b, h) + boff + n * 2048 + k * 1024); } while (0)
#define PG8_MMA(ai, bj, At, Bt) do { __builtin_amdgcn_s_setprio(1); _Pragma("unroll") for (int m = 0; m < 4; ++m) _Pragma("unroll") for (int n = 0; n < 2; ++n) _Pragma("unroll") for (int k = 0; k < 2; ++k) \
        acc[ai][bj][m][n] = __builtin_amdgcn_mfma_f32_16x16x32_bf16(Bt[n][k], At[m][k], acc[ai][bj][m][n], 0, 0, 0); __builtin_amdgcn_s_setprio(0); } while (0)
#define PG8_WAIT_V(n) asm volatile("s_waitcnt vmcnt(" #n ")" ::: "memory")
#define PG8_WAIT_L(n) asm volatile("s_waitcnt lgkmcnt(" #n ")" ::: "memory")
#define PG8_BAR __builtin_amdgcn_s_barrier()
#define PG8_SCHED __builtin_amdgcn_sched_barrier(0)
    Unit cur, nxt; int ui = 0;
    if (!S.next(0, cur)) return;
    f32x4 acc[2][2][4][2];
#pragma unroll
    for (int a = 0; a < 2; ++a)
#pragma unroll
        for (int b = 0; b < 2; ++b)
#pragma unroll
            for (int m = 0; m < 4; ++m)
#pragma unroll
                for (int n = 0; n < 2; ++n) acc[a][b][m][n] = (f32x4){0.f, 0.f, 0.f, 0.f};
    bf16x8 At[4][2], B0[2][2], B1[2][2];
    const char* cA = (const char*)g.A + (size_t)cur.pm * tstep; const char* cB = (const char*)g.Bt + (size_t)cur.pn * tstep;
    S.a_ready(cur);
    if constexpr (SP2) {
        PG8_STAGE(PG8_SB(0, 0), cB, voffB); PG8_STAGE(PG8_SB(0, 1), cB + hstep, voffB); PG8_STAGE(PG8_SA(0, 0), cA, voffA); PG8_STAGE(PG8_SA(0, 1), cA + hstep, voffA);
        if (wr == 1) PG8_BAR;
        PG8_WAIT_V(2); PG8_BAR;
        PG8_STAGE(PG8_SB(1, 0), cB + kstep, voffB); PG8_STAGE(PG8_SA(1, 0), cA + kstep, voffA); PG8_STAGE(PG8_SB(1, 1), cB + hstep + kstep, voffB);
        PG8_WAIT_V(6); PG8_BAR;
    } else {
        PG8_STAGE(PG8_SB(0, 0), cB, voffB); PG8_STAGE(PG8_SA(0, 0), cA, voffA); PG8_STAGE(PG8_SB(0, 1), cB + hstep, voffB); PG8_STAGE(PG8_SA(0, 1), cA + hstep, voffA);
        if (wr == 1) PG8_BAR;
        PG8_WAIT_V(4); PG8_BAR;
        PG8_STAGE(PG8_SB(1, 0), cB + kstep, voffB); PG8_STAGE(PG8_SA(1, 0), cA + kstep, voffA); PG8_STAGE(PG8_SB(1, 1), cB + hstep + kstep, voffB);
        PG8_WAIT_V(6); PG8_BAR;
    }
    for (;;) {
        const bool has_next = S.next(ui + 1, nxt);
        const char* nA = has_next ? (const char*)g.A + (size_t)nxt.pm * tstep : cA; const char* nB = has_next ? (const char*)g.Bt + (size_t)nxt.pn * tstep : cB;
        for (int t = 0; t < nt; t += 2) {
            const bool last = (t == nt - 2);
            const char* a1 = cA + (size_t)(t + 1) * kstep;
            const char* a2 = last ? nA : cA + (size_t)(t + 2) * kstep; const char* b2 = last ? nB : cB + (size_t)(t + 2) * kstep;
            const char* a3 = a2 + kstep; const char* b3 = b2 + kstep;
            if (last && has_next) S.a_ready(nxt);
            if constexpr (SP2) {
            PG8_LDB(B0, 0, 0); PG8_LDB(B1, 0, 1); PG8_SCHED; PG8_LDA(At, 0, 0); PG8_STAGE(PG8_SA(1, 1), a1 + hstep, voffA);
            PG8_WAIT_V(8); PG8_WAIT_L(0); PG8_BAR; PG8_MMA(0, 0, At, B0); PG8_MMA(0, 1, At, B1); PG8_BAR; PG8_SCHED;
            PG8_LDA(At, 0, 1); PG8_STAGE(PG8_SB(0, 0), b2, voffB); PG8_STAGE(PG8_SB(0, 1), b2 + hstep, voffB); PG8_STAGE(PG8_SA(0, 0), a2, voffA);
            PG8_WAIT_V(8); PG8_WAIT_L(0); PG8_BAR; PG8_MMA(1, 0, At, B0); PG8_MMA(1, 1, At, B1); PG8_BAR; PG8_SCHED;
            PG8_LDB(B0, 1, 0); PG8_LDB(B1, 1, 1); PG8_SCHED; PG8_LDA(At, 1, 0); PG8_STAGE(PG8_SA(0, 1), a2 + hstep, voffA);
            PG8_WAIT_V(8); PG8_WAIT_L(0); PG8_BAR; PG8_MMA(0, 0, At, B0); PG8_MMA(0, 1, At, B1); PG8_BAR; PG8_SCHED;
            PG8_LDA(At, 1, 1); PG8_STAGE(PG8_SB(1, 0), b3, voffB); PG8_STAGE(PG8_SB(1, 1), b3 + hstep, voffB); PG8_STAGE(PG8_SA(1, 0), a3, voffA);
            PG8_WAIT_V(8); PG8_WAIT_L(0); PG8_BAR; PG8_MMA(1, 0, At, B0); PG8_MMA(1, 1, At, B1); PG8_BAR; PG8_SCHED;
            } else {
            PG8_LDB(B0, 0, 0); PG8_SCHED; PG8_LDA(At, 0, 0); PG8_STAGE(PG8_SA(1, 1), a1 + hstep, voffA);
            PG8_WAIT_L(8); PG8_BAR; PG8_WAIT_L(0); PG8_MMA(0, 0, At, B0); PG8_BAR; PG8_SCHED;
            PG8_LDB(B1, 0, 1); PG8_STAGE(PG8_SB(0, 0), b2, voffB);
            PG8_BAR; PG8_WAIT_L(0); PG8_MMA(0, 1, At, B1); PG8_BAR;
            PG8_LDA(At, 0, 1); PG8_STAGE(PG8_SA(0, 0), a2, voffA);
            PG8_BAR; PG8_WAIT_L(0); PG8_MMA(1, 0, At, B0); PG8_BAR; PG8_SCHED;
            PG8_STAGE(PG8_SB(0, 1), b2 + hstep, voffB);
            PG8_WAIT_V(6); PG8_BAR; PG8_MMA(1, 1, At, B1); PG8_BAR;
            PG8_LDB(B0, 1, 0); PG8_SCHED; PG8_LDA(At, 1, 0); PG8_STAGE(PG8_SA(0, 1), a2 + hstep, voffA);
            PG8_WAIT_L(8); PG8_BAR; PG8_WAIT_L(0); PG8_MMA(0, 0, At, B0); PG8_BAR; PG8_SCHED;
            PG8_LDB(B1, 1, 1); PG8_STAGE(PG8_SB(1, 0), b3, voffB);
            PG8_BAR; PG8_WAIT_L(0); PG8_MMA(0, 1, At, B1); PG8_BAR;
            PG8_LDA(At, 1, 1); PG8_STAGE(PG8_SA(1, 0), a3, voffA);
            PG8_BAR; PG8_WAIT_L(0); PG8_MMA(1, 0, At, B0); PG8_BAR; PG8_SCHED;
            PG8_STAGE(PG8_SB(1, 1), b3 + hstep, voffB);
            PG8_WAIT_V(6); PG8_BAR; PG8_MMA(1, 1, At, B1); PG8_BAR;
            }
        }
        if constexpr (ALIGN_EPI) { if (wr == 0) PG8_BAR; }
        if constexpr (!Epi::AFTER_DRAIN) { E(acc, cur, wr, wc, fr, fq); S.done(cur); }
        if (!has_next) break;
#pragma unroll
        for (int a = 0; a < 2; ++a)
#pragma unroll
            for (int b = 0; b < 2; ++b)
#pragma unroll
                for (int m = 0; m < 4; ++m)
#pragma unroll
                    for (int n = 0; n < 2; ++n) acc[a][b][m][n] = (f32x4){0.f, 0.f, 0.f, 0.f};
        cur = nxt; cA = nA; cB = nB; ++ui;
        if constexpr (ALIGN_EPI) { if (wr == 1) PG8_BAR; }
    }
    PG8_WAIT_V(0);
    if constexpr (!ALIGN_EPI) { if (wr == 0) PG8_BAR; }
    PG8_BAR;
    if constexpr (Epi::AFTER_DRAIN) { E.fused(acc, cur, wr, wc, fr, fq, lds, wid, lane); S.done(cur); }
#undef PG8_SA
#undef PG8_SB
#undef PG8_STAGE
#undef PG8_LDA
#undef PG8_LDB
#undef PG8_MMA
#undef PG8_WAIT_V
#undef PG8_WAIT_L
#undef PG8_BAR
#undef PG8_SCHED
}
}
constexpr int BATCH = 4, SEQ = 8192, DM = 2048, M_TOK = BATCH * SEQ;
constexpr int NHEAD = 4, HD = 128, VD = 256, ATT_W = 1024, CONV_CH = 1024, CONV_W = 31, IN_COLS = 5120, FFN = 5632;
constexpr float EPS_RMS = 1e-6f, EPS_LN = 1e-5f, LAMBDA_INIT = 0.2f;
constexpr float QSCALE = 0.08838834764831845f * 1.4426950408889634f;
constexpr int NTHREADS = 512, NWAVES = 8;

constexpr size_t MiB = 1u << 20;
constexpr size_t WS_COS = 1 * MiB, WS_SIN = 3 * MiB;
constexpr size_t WS_WIN = 8 * MiB;
constexpr size_t WS_WV = 24 * MiB;
constexpr size_t WS_WOUT = 28 * MiB;
constexpr size_t WS_WGU = 36 * MiB;
constexpr size_t WS_WDN = 80 * MiB;
constexpr size_t WS_XN = 104 * MiB;
constexpr size_t WS_Q = 232 * MiB, WS_K = 296 * MiB, WS_VT = 360 * MiB, WS_U = 424 * MiB, WS_MIX = 488 * MiB;
constexpr size_t WS_ACT = 232 * MiB;
constexpr size_t WS_END = 616 * MiB;

#define LAS __attribute__((address_space(3)))
typedef unsigned short bf16;
typedef unsigned v4u __attribute__((ext_vector_type(4)));
typedef unsigned v2u __attribute__((ext_vector_type(2)));
typedef float f32x4 __attribute__((ext_vector_type(4)));
typedef float f32x2 __attribute__((ext_vector_type(2)));
typedef short bf16x8 __attribute__((ext_vector_type(8)));
typedef float f32x16 __attribute__((ext_vector_type(16)));
constexpr int LDS_BYTES = 131072 + 4096 + 64;
constexpr int MISC_OFF = 131072, BARST_OFF = 131072 + 4096;
constexpr size_t WS_BAR = 0, BAR_ZERO_BYTES = 16384;

__device__ __forceinline__ unsigned f2bf(float f) { unsigned u = __builtin_bit_cast(unsigned, f); return (u + 0x7fffu + ((u >> 16) & 1u)) >> 16; }
__device__ __forceinline__ unsigned pk2(float lo, float hi) { return pg8::cvt_pk_bf16(lo, hi); }
__device__ __forceinline__ float bflo(unsigned w) { return __builtin_bit_cast(float, w << 16); }
__device__ __forceinline__ float bfhi(unsigned w) { return __builtin_bit_cast(float, w & 0xffff0000u); }
__device__ __forceinline__ float wave_sum(float v) {
#pragma unroll
    for (int o = 1; o < 64; o <<= 1) v += __shfl_xor(v, o);
    return v;
}
__device__ __forceinline__ float wave_max(float v) {
#pragma unroll
    for (int o = 1; o < 64; o <<= 1) v = fmaxf(v, __shfl_xor(v, o));
    return v;
}
#define LDS_WAIT() asm volatile("s_waitcnt lgkmcnt(0)" ::: "memory")

__device__ __forceinline__ void transpose_item(const float* W, int K, int N, int k0, int n0, bf16* dst, const float* kscale, LAS unsigned char* scr, int lane) {
    const int r = lane >> 4, c = lane & 15;
    f32x4 v[16];
#pragma unroll
    for (int j = 0; j < 8; ++j)
#pragma unroll
        for (int p = 0; p < 2; ++p) v[2 * j + p] = *(const f32x4*)(W + (size_t)(k0 + 8 * j + 2 * r + p) * N + n0 + 4 * c);
#pragma unroll
    for (int j = 0; j < 8; ++j) { const int k = 8 * j + 2 * r; float s0 = 1.0f, s1 = 1.0f; if (kscale) { const f32x2 sc = *(const f32x2*)(kscale + k0 + k); s0 = sc.x; s1 = sc.y; }
#pragma unroll
        for (int i = 0; i < 4; ++i) { const int n = 4 * c + i; *(LAS unsigned*)(scr + n * 128 + ((j ^ (c & 7)) << 4) + 4 * r) = pk2(v[2 * j][i] * s0, v[2 * j + 1][i] * s1); } }
    LDS_WAIT(); asm volatile("" ::: "memory");
    const int rr = lane >> 3, cc = lane & 7;
#pragma unroll
    for (int j = 0; j < 8; ++j) { const int n = 8 * j + rr; const v4u o = *(const LAS v4u*)(scr + n * 128 + ((cc ^ ((n >> 2) & 7)) << 4)); *(v4u*)(dst + (size_t)n * K + k0 + 8 * cc) = o; }
    LDS_WAIT(); asm volatile("" ::: "memory");
}
__device__ __forceinline__ void rms_load_gain(const float* g, f32x4 (&gg)[8], int lane) {
#pragma unroll
    for (int j = 0; j < 8; ++j) gg[j] = *(const f32x4*)(g + 256 * j + 8 * (lane & 31) + 4 * (lane >> 5));
}
__device__ __forceinline__ void rms_row_to_bf16(const float* xrow, const f32x4 (&gg)[8], bf16* orow, int lane) {
    const int lo = lane & 31, hi = lane >> 5;
    const f32x4* xr = (const f32x4*)xrow + 2 * lo + hi;
    f32x4 v[8]; float s = 0.f;
#pragma unroll
    for (int j = 0; j < 8; ++j) { v[j] = xr[64 * j]; s += (v[j].x * v[j].x + v[j].y * v[j].y) + (v[j].z * v[j].z + v[j].w * v[j].w); }
    const float rinv = 1.0f / sqrtf(wave_sum(s) * (1.f / DM) + EPS_RMS);
#pragma unroll
    for (int i = 0; i < 4; ++i) { v2u wa, wb;
        { const f32x4 x = v[2 * i], g = gg[2 * i]; wa.x = pk2(x.x * rinv * g.x, x.y * rinv * g.y); wa.y = pk2(x.z * rinv * g.z, x.w * rinv * g.w); }
        { const f32x4 x = v[2 * i + 1], g = gg[2 * i + 1]; wb.x = pk2(x.x * rinv * g.x, x.y * rinv * g.y); wb.y = pk2(x.z * rinv * g.z, x.w * rinv * g.w); }
        const auto rx = __builtin_amdgcn_permlane32_swap(wa.x, wb.x, false, false);
        const auto ry = __builtin_amdgcn_permlane32_swap(wa.y, wb.y, false, false);
        v4u w16; w16.x = rx[0]; w16.y = ry[0]; w16.z = rx[1]; w16.w = ry[1];
        *(v4u*)(orow + 256 * (2 * i + hi) + 8 * lo) = w16; }
}

struct Ptrs {
    const float *x, *norm1_g, *w_in, *q_norm_g, *k_norm_g, *lq1, *lk1, *lq2, *lk2, *subln_g, *conv_w, *conv_b, *conv_ln_g, *conv_ln_b, *w_out, *norm2_g, *w_gate, *w_up, *w_down;
    float* out;
    bf16 *Wt_in, *Wt_v, *Wt_out, *Wt_gu, *Wt_dn, *XN, *Q, *K, *VT, *U, *MIX, *ACT;
    float *COS, *SIN;
};

__device__ __forceinline__ void p0_prologue(const Ptrs& P, LAS unsigned char* lds, int gw, int NGW, int wave, int lane) {
    LAS unsigned char* scr = lds + wave * 16384;
    constexpr int I_IN = 32 * 80, I_OUT = 32 * 32, I_G = 32 * 88, I_D = 88 * 32;
    constexpr int NITEMS = I_IN + I_OUT + 2 * I_G + I_D;
    for (int it = gw; it < NITEMS; it += NGW) {
        int r = it;
        if (r < I_IN) { const int kb = r / 80, n0 = (r % 80) * 64; bf16* dst;
            if (n0 < 2048) dst = P.Wt_in + (size_t)n0 * DM;
            else if (n0 < 3072) dst = P.Wt_v + (size_t)(n0 - 2048) * DM;
            else if (n0 < 4096) { const int ch = n0 - 3072; dst = P.Wt_in + (size_t)(2048 + (ch >> 7) * 256 + (ch & 127)) * DM; }
            else { const int ch = n0 - 4096; dst = P.Wt_in + (size_t)(2048 + (ch >> 7) * 256 + 128 + (ch & 127)) * DM; }
            transpose_item(P.w_in, DM, IN_COLS, kb * 64, n0, dst, nullptr, scr, lane); continue; }
        r -= I_IN;
        if (r < I_OUT) { const int kb = r / 32, n0 = (r % 32) * 64; transpose_item(P.w_out, DM, DM, kb * 64, n0, P.Wt_out + (size_t)n0 * DM, nullptr, scr, lane); continue; }
        r -= I_OUT;
        if (r < I_G) { const int kb = r / 88, n0 = (r % 88) * 64; transpose_item(P.w_gate, DM, FFN, kb * 64, n0, P.Wt_gu + (size_t)((n0 >> 7) * 256 + (n0 & 127)) * DM, nullptr, scr, lane); continue; }
        r -= I_G;
        if (r < I_G) { const int kb = r / 88, n0 = (r % 88) * 64; transpose_item(P.w_up, DM, FFN, kb * 64, n0, P.Wt_gu + (size_t)((n0 >> 7) * 256 + 128 + (n0 & 127)) * DM, nullptr, scr, lane); continue; }
        r -= I_G;
        { const int kb = r / 32, n0 = (r % 32) * 64; transpose_item(P.w_down, FFN, DM, kb * 64, n0, P.Wt_dn + (size_t)n0 * FFN, nullptr, scr, lane); }
    }
    { f32x4 gg[8]; rms_load_gain(P.norm1_g, gg, lane);
      for (int m = gw; m < M_TOK; m += NGW) rms_row_to_bf16(P.x + (size_t)m * DM, gg, P.XN + (size_t)m * DM, lane); }
    for (int i = gw * 64 + lane; i < SEQ * 64; i += NGW * 64) {
        const int pos = i >> 6, j = i & 63;
        const float inv = (float)exp2(-(double)j * (13.287712379549449 / 64.0));
        const float ang = (float)pos * inv;
        double rev = (double)ang * 0.15915494309189535; rev -= rint(rev);
        const float fr = (float)rev;
        P.COS[i] = __builtin_amdgcn_cosf(fr); P.SIN[i] = __builtin_amdgcn_sinf(fr);
    }
}

__device__ __forceinline__ void p2_qk_norm_rope(const Ptrs& P, int gw, int NGW, int lane) {
    const int sub = lane & 7, grp = lane >> 3;
    f32x4 gq[4], gk[4];
#pragma unroll
    for (int i = 0; i < 4; ++i) { const int o = sub * 8 + (i & 1) * 4 + (i >> 1) * 64; gq[i] = *(const f32x4*)(P.q_norm_g + o); gk[i] = *(const f32x4*)(P.k_norm_g + o); }
    for (int row = gw; row < M_TOK; row += NGW) {
        bf16* pq = P.Q + (size_t)row * 1024 + grp * 128 + sub * 8; bf16* pk = P.K + (size_t)row * 1024 + grp * 128 + sub * 8;
        const v4u q1 = *(const v4u*)pq, q2 = *(const v4u*)(pq + 64), k1 = *(const v4u*)pk, k2 = *(const v4u*)(pk + 64);
        const int pos = row & (SEQ - 1);
        const f32x4 c0 = *(const f32x4*)(P.COS + pos * 64 + sub * 8), c1 = *(const f32x4*)(P.COS + pos * 64 + sub * 8 + 4);
        const f32x4 s0 = *(const f32x4*)(P.SIN + pos * 64 + sub * 8), s1 = *(const f32x4*)(P.SIN + pos * 64 + sub * 8 + 4);
#pragma unroll
        for (int which = 0; which < 2; ++which) {
            const v4u r1 = which ? k1 : q1, r2 = which ? k2 : q2;
            float t1[8], t2[8];
#pragma unroll
            for (int j = 0; j < 4; ++j) { t1[2 * j] = bflo(r1[j]); t1[2 * j + 1] = bfhi(r1[j]); t2[2 * j] = bflo(r2[j]); t2[2 * j + 1] = bfhi(r2[j]); }
            float ss = 0.f;
#pragma unroll
            for (int j = 0; j < 8; ++j) ss += t1[j] * t1[j] + t2[j] * t2[j];
            ss += __shfl_xor(ss, 1); ss += __shfl_xor(ss, 2); ss += __shfl_xor(ss, 4);
            const float rinv = (1.0f / sqrtf(ss * (1.f / HD) + EPS_RMS)) * (which ? 1.0f : QSCALE);
            float o1[8], o2[8];
#pragma unroll
            for (int j = 0; j < 8; ++j) {
                const float cc = j < 4 ? c0[j & 3] : c1[j & 3], sn = j < 4 ? s0[j & 3] : s1[j & 3];
                const float ga = which ? (j < 4 ? gk[0][j & 3] : gk[1][j & 3]) : (j < 4 ? gq[0][j & 3] : gq[1][j & 3]);
                const float gb = which ? (j < 4 ? gk[2][j & 3] : gk[3][j & 3]) : (j < 4 ? gq[2][j & 3] : gq[3][j & 3]);
                const float n1 = t1[j] * rinv * ga, n2 = t2[j] * rinv * gb;
                o1[j] = n1 * cc - n2 * sn; o2[j] = n2 * cc + n1 * sn;
            }
            v4u w1, w2;
#pragma unroll
            for (int j = 0; j < 4; ++j) { w1[j] = pk2(o1[2 * j], o1[2 * j + 1]); w2[j] = pk2(o2[2 * j], o2[2 * j + 1]); }
            bf16* p = which ? pk : pq;
            *(v4u*)p = w1; *(v4u*)(p + 64) = w2;
        }
    }
}

__device__ __forceinline__ void glds16c(const void* sbase, unsigned voff, unsigned lds_dst) {
    unsigned keep;
    asm volatile("s_mov_b32 %0, m0\n\ts_mov_b32 m0, %3\n\ts_nop 0\n\tglobal_load_lds_dwordx4 %1, %2\n\ts_mov_b32 m0, %0" : "=&s"(keep) : "v"(voff), "s"(sbase), "s"(lds_dst) : "memory");
}
#define CBAR() do { LDS_WAIT(); asm volatile("" ::: "memory"); __builtin_amdgcn_s_barrier(); asm volatile("" ::: "memory"); } while (0)
#define CONV_ISSUE(item_) do { const int row0_ = (item_) * 16, s0_ = row0_ & (SEQ - 1); \
        _Pragma("nounroll") for (int k_ = 0; k_ < 12; ++k_) { const int p_ = wave + 8 * k_; if (p_ < 92) { const int r_ = p_ >> 1; const int rr_ = (s0_ - 30 + r_ < 0) ? 30 : r_; \
            glds16c((const char*)P.U + ((size_t)(row0_ - 30 + rr_) * 2048 + (size_t)(p_ & 1) * 1024), (unsigned)lane * 16u, lds0 + (unsigned)p_ * 1024u); } } } while (0)
__device__ __forceinline__ void p3_conv(const Ptrs& P, LAS unsigned char* lds, int first, int stride, int tid, int wave, int lane) {
    const int ch = 2 * tid;
    constexpr int NITEMS = M_TOK / 16, OT_OFF = 94208;
    f32x2 w[CONV_W];
#pragma unroll
    for (int k = 0; k < CONV_W; ++k) w[k] = *(const f32x2*)(P.conv_w + k * CONV_CH + ch);
    const f32x2 cb = *(const f32x2*)(P.conv_b + ch), lg = *(const f32x2*)(P.conv_ln_g + ch), lb = *(const f32x2*)(P.conv_ln_b + ch);
    LAS float* red = (LAS float*)(lds + MISC_OFF);
    LAS float* stat = red + 256;
    const unsigned lds0 = (unsigned)__builtin_amdgcn_readfirstlane((int)(unsigned)(uintptr_t)lds);
    asm volatile("s_waitcnt vmcnt(0)" ::: "memory");
#pragma unroll
    for (int k = 0; k < CONV_W; ++k) asm volatile("" : "+v"(w[k]));
    if (first < NITEMS) CONV_ISSUE(first);
    for (int item = first; item < NITEMS; item += stride) {
        const int row0 = item * 16, s0 = row0 & (SEQ - 1);
        asm volatile("s_waitcnt vmcnt(0)" ::: "memory");
        CBAR();
        unsigned uv[46];
#pragma unroll
        for (int r = 0; r < 46; ++r) { const int neg = (s0 - 30 + r) >> 31;
            uv[r] = *(const LAS unsigned*)(lds + r * 2048 + tid * 4) & ~(unsigned)neg; }
        CBAR();
        if (item + stride < NITEMS) CONV_ISSUE(item + stride);
        f32x2 a[16];
#pragma unroll
        for (int t = 0; t < 16; ++t) a[t] = cb;
#pragma unroll
        for (int r = 0; r < 46; ++r) {
            const f32x2 u = (f32x2){bflo(uv[r]), bfhi(uv[r])};
#pragma unroll
            for (int t = 0; t < 16; ++t) { const int k = r - t; if (k >= 0 && k < CONV_W) a[t] += u * w[k]; }
        }
#pragma unroll
        for (int t = 0; t < 16; ++t) {
            const float s1 = wave_sum(a[t].x + a[t].y), s2 = wave_sum(a[t].x * a[t].x + a[t].y * a[t].y);
            if (lane == 0) { red[(wave * 16 + t) * 2] = s1; red[(wave * 16 + t) * 2 + 1] = s2; }
        }
        CBAR();
        if (tid < 16) { float s1 = 0.f, s2 = 0.f;
#pragma unroll
            for (int ww = 0; ww < 8; ++ww) { s1 += red[(ww * 16 + tid) * 2]; s2 += red[(ww * 16 + tid) * 2 + 1]; }
            const float mu = s1 * (1.f / CONV_CH), var = fmaxf(s2 * (1.f / CONV_CH) - mu * mu, 0.f);
            stat[tid * 2] = mu; stat[tid * 2 + 1] = 1.0f / sqrtf(var + EPS_LN); }
        CBAR();
#pragma unroll
        for (int t = 0; t < 16; ++t) {
            const float mu = stat[t * 2], rs = stat[t * 2 + 1];
            const float y0 = (a[t].x - mu) * rs * lg.x + lb.x, y1 = (a[t].y - mu) * rs * lg.y + lb.y;
            *(LAS unsigned*)(lds + OT_OFF + t * 2048 + tid * 4) = pk2(y0 * pg8::sigmoid_fast(y0), y1 * pg8::sigmoid_fast(y1));
        }
        CBAR();
#pragma unroll
        for (int k = 0; k < 4; ++k) { const int c = tid + 512 * k; const v4u v = *(const LAS v4u*)(lds + OT_OFF + c * 16);
            *(v4u*)((char*)P.MIX + ((size_t)(row0 + (c >> 7)) * DM + ATT_W) * 2 + (size_t)(c & 127) * 16) = v; }
        CBAR();
    }
    asm volatile("s_waitcnt vmcnt(0)" ::: "memory");
}
#undef CONV_ISSUE
#undef CBAR

namespace att {
constexpr int BUF = 65536, V_OFF = 32768;
__device__ __forceinline__ void glds16(const void* sbase, unsigned voff, unsigned lds_dst) {
    unsigned keep;
    asm volatile("s_mov_b32 %0, m0\n\ts_mov_b32 m0, %3\n\ts_nop 0\n\tglobal_load_lds_dwordx4 %1, %2\n\ts_mov_b32 m0, %0" : "=&s"(keep) : "v"(voff), "s"(sbase), "s"(lds_dst) : "memory");
}
__device__ __forceinline__ int pi32(int i) { return (i & ~12) | ((i & 4) << 1) | ((i & 8) >> 1); }
#define ATT_WAIT_V(n) asm volatile("s_waitcnt vmcnt(" #n ")" ::: "memory")
#define ATT_BAR() do { asm volatile("" ::: "memory"); __builtin_amdgcn_s_barrier(); asm volatile("" ::: "memory"); } while (0)

__device__ __forceinline__ void attn_block(LAS unsigned char* lds, const Ptrs& P, int b, int h, int qb, float negMb, float lam, int tid, int wid, int lane) {
    const int comp = wid & 1, quarter = wid >> 1, l31 = lane & 31, hh = lane >> 5;
    const int NT = 2 * qb + 2;
    const size_t tok0 = (size_t)b * SEQ;
    const int qpos = qb * 128 + quarter * 32 + l31;
    bf16x8 qf[8];
    { const bf16* qp = P.Q + (tok0 + qpos) * 1024 + h * 256 + comp * 128 + hh * 8;
#pragma unroll
      for (int ks = 0; ks < 8; ++ks) qf[ks] = *(const bf16x8*)(qp + ks * 16); }
    const unsigned ldsw = (unsigned)wid * 4096u;
    const unsigned lds0 = (unsigned)__builtin_amdgcn_readfirstlane((int)(unsigned)(uintptr_t)lds);
    unsigned kb0, kx16, vb0, vy16;
    { int ln_ = lane; asm volatile("" : "+v"(ln_));
      kb0 = (unsigned)(((16 * (wid & 3) + (ln_ >> 4)) * 1024 + h * 256 + (wid >> 2) * 128) * 2); kx16 = (unsigned)(((ln_ & 15) ^ (ln_ >> 4)) << 4);
      vb0 = (unsigned)(((h * 256 + 32 * wid + (ln_ >> 3)) * M_TOK) * 2); vy16 = (unsigned)(((ln_ & 7) ^ (ln_ >> 4)) << 4);
      asm volatile("" : "+v"(kb0), "+v"(kx16), "+v"(vb0), "+v"(vy16)); }
#define ATT_DMA(t, bufi) do { const char* kb_ = (const char*)P.K + (tok0 + (size_t)(t) * 64) * 2048; const char* vb_ = (const char*)P.VT + (tok0 + (size_t)(t) * 64) * 2; \
        _Pragma("unroll") for (int pp = 0; pp < 4; ++pp) glds16(kb_, kb0 + pp * 8192 + (kx16 ^ (64 * pp)), lds0 + (bufi) * BUF + ldsw + pp * 1024); \
        _Pragma("unroll") for (int pp = 0; pp < 4; ++pp) glds16(vb_, vb0 + pp * (8 * M_TOK * 2) + (vy16 ^ (64 * (pp & 1))), lds0 + (bufi) * BUF + V_OFF + ldsw + pp * 1024); } while (0)
    f32x16 o[8];
#pragma unroll
    for (int e = 0; e < 8; ++e)
#pragma unroll
        for (int r = 0; r < 16; ++r) o[e][r] = 0.f;
    float lsum = 0.f;
    ATT_WAIT_V(0);
#pragma unroll
    for (int ks = 0; ks < 8; ++ks) asm volatile("" : "+v"(qf[ks]));
    ATT_DMA(0, 0);
    const bool early = wid < 4;
    for (int t = 0; t < NT; ++t) {
        ATT_WAIT_V(0);
        LDS_WAIT();
        ATT_BAR();
        const bool more = t + 1 < NT;
        if (more && early) ATT_DMA(t + 1, (t + 1) & 1);
        const bool active = (quarter >= 2) || more;
        const LAS unsigned char* base = lds + (t & 1) * BUF;
        int ln2 = lane; asm volatile("" : "+v"(ln2));
        const int l31b = ln2 & 31, hhb = ln2 >> 5;
        const int krow = pi32(l31b), kx = krow & 15;
        const int koffr = comp * 16384 + krow * 256;
        const int vx = (l31b >> 1) & 7;
        const int voffr = V_OFF + l31b * 128;
#pragma unroll
        for (int T = 0; T < 2; ++T) {
            if (T == 1 && more && !early) ATT_DMA(t + 1, (t + 1) & 1);
            if (active) {
                f32x16 s;
#pragma unroll
                for (int r = 0; r < 16; ++r) s[r] = negMb;
#pragma unroll
                for (int ks = 0; ks < 8; ++ks) {
                    const bf16x8 kf = *(const LAS bf16x8*)(base + koffr + T * 8192 + (((2 * ks + hhb) ^ kx) << 4));
                    s = __builtin_amdgcn_mfma_f32_32x32x16_bf16(kf, qf[ks], s, 0, 0, 0);
                }
                float ps = 0.f;
#pragma unroll
                for (int r = 0; r < 16; ++r) { s[r] = __builtin_amdgcn_exp2f(s[r]); ps += s[r]; }
                lsum += ps;
#pragma unroll
                for (int sI = 0; sI < 2; ++sI) { v4u w;
#pragma unroll
                    for (int j = 0; j < 4; ++j) w[j] = pk2(s[8 * sI + 2 * j], s[8 * sI + 2 * j + 1]);
                    const bf16x8 pf = __builtin_bit_cast(bf16x8, w);
                    const LAS unsigned char* vb = base + voffr + (((2 * (2 * T + sI) + hhb) ^ vx) << 4);
#pragma unroll
                    for (int e = 0; e < 8; ++e) {
                        const bf16x8 vf = *(const LAS bf16x8*)(vb + e * 4096);
                        o[e] = __builtin_amdgcn_mfma_f32_32x32x16_bf16(vf, pf, o[e], 0, 0, 0);
                    }
                }
            }
        }
    }
    LDS_WAIT();
    ATT_BAR();
    const float ltot = lsum + __shfl_xor(lsum, 32);
    const float inv = 1.0f / ltot;
    int ln3 = lane; asm volatile("" : "+v"(ln3));
    const int hh3 = ln3 >> 5, qpos3 = qb * 128 + quarter * 32 + (ln3 & 31);
    LAS unsigned char* xb = lds + quarter * 32768 + ln3 * 16;
    if (comp == 1) {
        const float sc = lam * inv;
#pragma unroll
        for (int e = 0; e < 8; ++e)
#pragma unroll
            for (int r4 = 0; r4 < 4; ++r4) *(LAS f32x4*)(xb + (e * 4 + r4) * 1024) = (f32x4){o[e][4 * r4] * sc, o[e][4 * r4 + 1] * sc, o[e][4 * r4 + 2] * sc, o[e][4 * r4 + 3] * sc};
    }
    LDS_WAIT();
    ATT_BAR();
    if (comp == 0) {
        float ss = 0.f;
#pragma unroll
        for (int e = 0; e < 8; ++e)
#pragma unroll
            for (int r4 = 0; r4 < 4; ++r4) { const f32x4 x1 = *(const LAS f32x4*)(xb + (e * 4 + r4) * 1024);
#pragma unroll
                for (int i = 0; i < 4; ++i) { const float v = o[e][4 * r4 + i] * inv - x1[i]; o[e][4 * r4 + i] = v; ss += v * v; } }
        ss += __shfl_xor(ss, 32);
        const float rn = (1.0f / sqrtf(ss * (1.f / VD) + EPS_RMS)) * (1.0f - LAMBDA_INIT);
        bf16* orow = P.MIX + (tok0 + qpos3) * DM + h * 256 + 8 * hh3;
        const LAS float* gp = (const LAS float*)(lds + MISC_OFF + 3072) + 4 * hh3;
#pragma unroll
        for (int e = 0; e < 8; ++e)
#pragma unroll
            for (int i2 = 0; i2 < 2; ++i2) { v2u wab[2];
#pragma unroll
                for (int q = 0; q < 2; ++q) { const int r4 = 2 * i2 + q; const f32x4 g = *(const LAS f32x4*)(gp + 32 * e + 8 * r4);
                    wab[q].x = pk2(o[e][4 * r4] * rn * g[0], o[e][4 * r4 + 1] * rn * g[1]); wab[q].y = pk2(o[e][4 * r4 + 2] * rn * g[2], o[e][4 * r4 + 3] * rn * g[3]); }
                const auto rx = __builtin_amdgcn_permlane32_swap(wab[0].x, wab[1].x, false, false);
                const auto ry = __builtin_amdgcn_permlane32_swap(wab[0].y, wab[1].y, false, false);
                v4u w16; w16.x = rx[0]; w16.y = ry[0]; w16.z = rx[1]; w16.w = ry[1];
                *(v4u*)(orow + 32 * e + 16 * i2) = w16; }
    }
    LDS_WAIT();
    ATT_BAR();
#undef ATT_DMA
}
}

#define XB_TMO      128
#define XB_XCNT(j)  (256  + 64 * (j))
#define XB_XSUB(j)  (1280 + 64 * (j))
#define XB_XGEN(j)  (2304 + 64 * (j))
#define XB_TOP      3328
#define XB_TOPGEN   3392
#define XCD_BAR_WORDS 3456
#define XB_SPIN_CAP (1u << 18)

__device__ __forceinline__ unsigned xb_ld(unsigned* p)              { return __hip_atomic_load(p, __ATOMIC_RELAXED, __HIP_MEMORY_SCOPE_AGENT); }
__device__ __forceinline__ unsigned xb_add(unsigned* p, unsigned v) { return __hip_atomic_fetch_add(p, v, __ATOMIC_RELAXED, __HIP_MEMORY_SCOPE_AGENT); }
__device__ __forceinline__ unsigned xb_xcc_id() { return (unsigned)__builtin_amdgcn_s_getreg((3 << 11) | 20) & 0xFu; }
#define XB_SPIN(cond, bar) do { unsigned _sp = 0; while (cond) { __builtin_amdgcn_s_sleep(1); \
    if ((++_sp & 255u) == 0u) { if (xb_ld(&(bar)[XB_TMO])) break; if (_sp > XB_SPIN_CAP) { atomicAdd(&(bar)[XB_TMO], 1u); break; } } } } while (0)

struct XcdBarrier {
    unsigned* bar; unsigned x;
    volatile LAS unsigned* st;
};

__device__ __forceinline__ XcdBarrier xcd_barrier_post(unsigned* bar, volatile LAS unsigned* st) {
    XcdBarrier b; b.bar = bar; b.x = xb_xcc_id(); b.st = st;
    if (threadIdx.x == 0) (void)xb_add(&bar[XB_XCNT(b.x)], 1u);
    return b;
}
__device__ __forceinline__ void xcd_barrier_complete(unsigned* bar, unsigned x, unsigned& nloc, unsigned& nx) {
    const unsigned G = gridDim.x * gridDim.y * gridDim.z;
    unsigned sum, cnt, mine, sp = 0u;
    for (;;) {
        sum = 0u; cnt = 0u; mine = 0u;
#pragma unroll
        for (unsigned j = 0; j < 16; ++j) { const unsigned c = xb_ld(&bar[XB_XCNT(j)]); sum += c; cnt += (c > 0u) ? 1u : 0u; mine = (j == x) ? c : mine; }
        if (sum == G) break;
        __builtin_amdgcn_s_sleep(1);
        if ((++sp & 255u) == 0u) { if (xb_ld(&bar[XB_TMO])) break; if (sp > XB_SPIN_CAP) { atomicAdd(&bar[XB_TMO], 1u); break; } }
    }
    nloc = mine > 0u ? mine : 1u; nx = cnt > 0u ? cnt : 1u;
}

__device__ __forceinline__ void xcd_barrier(const XcdBarrier& b) {
    asm volatile("s_waitcnt vmcnt(0)" ::: "memory");
    __syncthreads();
    if (threadIdx.x == 0) {
        unsigned* bar = b.bar;
        __builtin_amdgcn_s_waitcnt(0);
        unsigned nloc = b.st[0], nx = b.st[1];
        if (nloc == 0u) { xcd_barrier_complete(bar, b.x, nloc, nx); b.st[0] = nloc; b.st[1] = nx; }
        const unsigned old = xb_add(&bar[XB_XSUB(b.x)], 1u);
        const unsigned gen = old / nloc;
        if (old + 1u == (gen + 1u) * nloc) {
            __builtin_amdgcn_fence(__ATOMIC_RELEASE, "agent");
            asm volatile("s_waitcnt vmcnt(0)" ::: "memory");
            const unsigned og = xb_add(&bar[XB_TOP], 1u);
            const unsigned tg = og / nx;
            if (og + 1u == (tg + 1u) * nx) xb_add(&bar[XB_TOPGEN], 1u);
            else XB_SPIN(xb_ld(&bar[XB_TOPGEN]) == tg, bar);
            __builtin_amdgcn_fence(__ATOMIC_ACQUIRE, "agent");
            xb_add(&bar[XB_XGEN(b.x)], 1u);
            asm volatile("s_waitcnt vmcnt(0)" ::: "memory");
        } else {
            XB_SPIN(xb_ld(&bar[XB_XGEN(b.x)]) == gen, bar);
            __builtin_amdgcn_fence(__ATOMIC_ACQUIRE, "agent");
            asm volatile("s_waitcnt vmcnt(0)" ::: "memory");
        }
    }
    __syncthreads();
}

struct Args { const float* in[19]; float* out; unsigned char* ws; int ph_lo, ph_hi; };
constexpr int N_PHASES = 8;

__global__ void __launch_bounds__(NTHREADS) mega_fwd(Args args) {
    extern __shared__ __attribute__((aligned(16))) unsigned char lds_raw[];
    LAS unsigned char* lds = (LAS unsigned char*)lds_raw;
    const int tid = threadIdx.x, lane = tid & 63, wave = __builtin_amdgcn_readfirstlane(tid >> 6);
    const int G = gridDim.x, bx = blockIdx.x;
    const int vcu = (G % 8 == 0) ? (bx % 8) * (G / 8) + bx / 8 : bx;
    const int gw = vcu * NWAVES + wave, NGW = G * NWAVES;
    unsigned char* ws = args.ws;
#define MAKE_P() Ptrs P; { unsigned char* w_ = args.ws; asm volatile("" : "+s"(w_)); \
    P.x = args.in[0]; P.norm1_g = args.in[1]; P.w_in = args.in[2]; P.q_norm_g = args.in[3]; P.k_norm_g = args.in[4]; P.lq1 = args.in[5]; P.lk1 = args.in[6]; P.lq2 = args.in[7]; P.lk2 = args.in[8]; \
    P.subln_g = args.in[9]; P.conv_w = args.in[10]; P.conv_b = args.in[11]; P.conv_ln_g = args.in[12]; P.conv_ln_b = args.in[13]; P.w_out = args.in[14]; P.norm2_g = args.in[15]; \
    P.w_gate = args.in[16]; P.w_up = args.in[17]; P.w_down = args.in[18]; P.out = args.out; \
    P.Wt_in = (bf16*)(w_ + WS_WIN); P.Wt_v = (bf16*)(w_ + WS_WV); P.Wt_out = (bf16*)(w_ + WS_WOUT); P.Wt_gu = (bf16*)(w_ + WS_WGU); P.Wt_dn = (bf16*)(w_ + WS_WDN); \
    P.XN = (bf16*)(w_ + WS_XN); P.Q = (bf16*)(w_ + WS_Q); P.K = (bf16*)(w_ + WS_K); P.VT = (bf16*)(w_ + WS_VT); P.U = (bf16*)(w_ + WS_U); P.MIX = (bf16*)(w_ + WS_MIX); P.ACT = (bf16*)(w_ + WS_ACT); \
    P.COS = (float*)(w_ + WS_COS); P.SIN = (float*)(w_ + WS_SIN); }
    const int lo = args.ph_lo, hi = args.ph_hi;
    if (tid < 2) ((volatile LAS unsigned*)(lds + BARST_OFF))[tid] = 0u;
    __syncthreads();
    XcdBarrier gbar = xcd_barrier_post((unsigned*)(ws + WS_BAR), (volatile LAS unsigned*)(lds + BARST_OFF));
#ifndef PHASE_MASK
#define PHASE_MASK 0xff
#endif
#define IN(k) (((PHASE_MASK >> (k)) & 1) && lo <= (k) && (k) < hi)
#ifndef REP3
#define REP3 1
#endif
#ifndef REP6
#define REP6 1
#endif
#ifndef REP1
#define REP1 1
#endif
#define SEAM(k) do { if (IN(k) && IN((k) + 1)) { if (args.ph_hi > 1000) cooperative_groups::this_grid().sync(); else xcd_barrier(gbar); } } while (0)

    if (IN(0)) { MAKE_P(); p0_prologue(P, lds, gw, NGW, wave, lane); }
    SEAM(0);
    if (IN(1)) {
        MAKE_P();
        { pg8::Gemm g{P.XN, P.Wt_in, M_TOK, 4096, DM}; pg8::StaticOrder S; S.init(M_TOK, 4096, G, bx); S.rep = REP1; pg8::EpiProj E{P.Q, P.K, P.U};
          pg8::gemm_phase<pg8::EpiProj, pg8::StaticOrder, true, true>(lds, g, S, E); }
        { pg8::Gemm g{P.Wt_v, P.XN, 1024, M_TOK, DM}; pg8::StaticOrder S; S.init(1024, M_TOK, G, bx); pg8::EpiPlain E{P.VT, M_TOK};
          pg8::gemm_phase<pg8::EpiPlain, pg8::StaticOrder, true, true>(lds, g, S, E); }
    }
    SEAM(1);
    if (IN(2)) { MAKE_P(); p2_qk_norm_rope(P, gw, NGW, lane); }
    SEAM(2);
    if (IN(3)) {
        MAKE_P();
#ifndef NO_CONV
        p3_conv(P, lds, bx, G, tid, wave, lane);
#endif
        float lam, negMb;
        { const float a = P.lq1[lane] * P.lk1[lane] + P.lq1[lane + 64] * P.lk1[lane + 64], c = P.lq2[lane] * P.lk2[lane] + P.lq2[lane + 64] * P.lk2[lane + 64];
          lam = expf(wave_sum(a)) - expf(wave_sum(c)) + LAMBDA_INIT;
          const float gq = wave_max(fmaxf(fabsf(P.q_norm_g[lane]), fabsf(P.q_norm_g[lane + 64]))), gk = wave_max(fmaxf(fabsf(P.k_norm_g[lane]), fabsf(P.k_norm_g[lane + 64])));
          negMb = -(gq * gk * 11.313708498984761f * 1.4426950408889634f * 1.01f);
          lam = __builtin_bit_cast(float, __builtin_amdgcn_readfirstlane(__builtin_bit_cast(int, lam))); negMb = __builtin_bit_cast(float, __builtin_amdgcn_readfirstlane(__builtin_bit_cast(int, negMb))); }
#ifndef NO_ATT
        if (tid < 64) *(LAS f32x4*)(lds + MISC_OFF + 3072 + tid * 16) = *(const f32x4*)(P.subln_g + tid * 4);
        __syncthreads();
        for (int item = vcu; item < 512; item += G) {
            const int bh = item >> 5, pair = item & 31;
            for (int half = 0; half < 2 * REP3; ++half)
                att::attn_block(lds, P, bh >> 2, bh & 3, (half & 1) ? pair : 63 - pair, negMb, lam, tid, wave, lane);
        }
#endif
    }
    SEAM(3);
    if (IN(4)) { MAKE_P(); pg8::Gemm g{P.MIX, P.Wt_out, M_TOK, DM, DM}; pg8::StaticOrder S; S.init(M_TOK, DM, G, bx); pg8::EpiRes E{P.x, P.out, DM};
        pg8::gemm_phase<pg8::EpiRes, pg8::StaticOrder, true, true>(lds, g, S, E); }
    SEAM(4);
    if (IN(5)) { MAKE_P(); f32x4 gg[8]; rms_load_gain(P.norm2_g, gg, lane); for (int m = gw; m < M_TOK; m += NGW) rms_row_to_bf16(P.out + (size_t)m * DM, gg, P.XN + (size_t)m * DM, lane); }
    SEAM(5);
    if (IN(6)) { MAKE_P(); pg8::Gemm g{P.XN, P.Wt_gu, M_TOK, 2 * FFN, DM}; pg8::StaticOrder S; S.init(M_TOK, 2 * FFN, G, bx); S.rep = REP6; pg8::EpiSwiGLU E{P.ACT, FFN};
        pg8::gemm_phase<pg8::EpiSwiGLU, pg8::StaticOrder, true, true>(lds, g, S, E); }
    SEAM(6);
    if (IN(7)) { MAKE_P(); pg8::Gemm g{P.ACT, P.Wt_dn, M_TOK, DM, FFN}; pg8::StaticOrder S; S.init(M_TOK, DM, G, bx); pg8::EpiRes E{P.out, P.out, DM};
        pg8::gemm_phase<pg8::EpiRes, pg8::StaticOrder, true, true>(lds, g, S, E); }
#undef IN
#undef SEAM
}

#ifndef MK_MULTI
#define MK_MULTI 0
#endif
extern "C" void kernel_launch(void* const* d_in, const int* in_sizes, int n_in, void* d_out, int out_size, void* d_ws, size_t ws_size, hipStream_t stream) {
    static int grid = 0;
    if (grid == 0) {
        if (n_in != 19 || ws_size < WS_END) { fprintf(stderr, "kernel_launch: unexpected n_in %d / ws %zu\n", n_in, ws_size); grid = -1; return; }
        int dev = 0, cus = 0, per_cu = 0;
        hipGetDevice(&dev); hipDeviceGetAttribute(&cus, hipDeviceAttributeMultiprocessorCount, dev);
        if (hipFuncSetAttribute((const void*)mega_fwd, hipFuncAttributeMaxDynamicSharedMemorySize, LDS_BYTES) != hipSuccess) { fprintf(stderr, "kernel_launch: hipFuncSetAttribute failed\n"); }
        if (hipOccupancyMaxActiveBlocksPerMultiprocessor(&per_cu, (const void*)mega_fwd, NTHREADS, LDS_BYTES) != hipSuccess || per_cu < 1) { fprintf(stderr, "kernel_launch: occupancy query says %d\n", per_cu); per_cu = 1; }
        (void)hipGetLastError();
        grid = cus * per_cu;
        fprintf(stderr, "kernel_launch: grid %d (cus %d x %d)\n", grid, cus, per_cu);
    }
    if (grid < 0) return;
    if (hipMemsetAsync((char*)d_ws + WS_BAR, 0, BAR_ZERO_BYTES, stream) != hipSuccess) { fprintf(stderr, "kernel_launch: hipMemsetAsync failed\n"); return; }
    Args a{};
    for (int i = 0; i < 19; ++i) a.in[i] = (const float*)d_in[i];
    a.out = (float*)d_out; a.ws = (unsigned char*)d_ws;
#if MK_MULTI
    for (int ph = 0; ph < N_PHASES; ++ph) { a.ph_lo = ph; a.ph_hi = ph + 1; hipLaunchKernelGGL(mega_fwd, dim3(grid), dim3(NTHREADS), LDS_BYTES, stream, a); }
#else
    a.ph_lo = 0; a.ph_hi = N_PHASES;
    void* kargs[] = {(void*)&a};
    hipError_t e = hipLaunchCooperativeKernel((const void*)mega_fwd, dim3(grid), dim3(NTHREADS), kargs, LDS_BYTES, stream);
    if (e != hipSuccess) fprintf(stderr, "kernel_launch: cooperative launch failed: %s (grid %d)\n", hipGetErrorString(e), grid);
#endif
}
```

```cpp
#include <hip/hip_runtime.h>
#include <hip/hip_cooperative_groups.h>
#include <cstdio>
#include <cstdint>
namespace pg8 {
#define PG8_LAS __attribute__((address_space(3)))
typedef unsigned short bf16_t;
typedef short bf16x8 __attribute__((ext_vector_type(8)));
typedef float f32x4 __attribute__((ext_vector_type(4)));
typedef unsigned u32x4 __attribute__((ext_vector_type(4)));
constexpr int BM = 256, BK = 64, HALF = 128, HTB = HALF * BK * 2  , STAGE_BYTES = 8 * HTB, NXCD = 8, WGM = 8;

__host__ __device__ __forceinline__ int lds_byte(int r, int c) { const int st = (r >> 4) * 2 + (c >> 5), rr = r & 15, cc = c & 31, ob = rr * 64 + cc * 2; return st * 1024 + (ob ^ (((ob >> 9) & 1) << 5)); }
__host__ __device__ __forceinline__ void stage_rc(int b, int& R, int& C) { const int st = b / 1024, sb = b % 1024, swz = sb ^ (((sb >> 9) & 1) << 5); R = (st >> 1) * 16 + swz / 64; C = (st & 1) * 32 + (swz % 64) / 2; }
__host__ __device__ __forceinline__ int perm32(int rho) { const int n = rho >> 4, i = rho & 15; return 8 * (i >> 2) + 4 * n + (i & 3); }

struct Unit { int pm, pn; };
struct Gemm { const bf16_t* A; const bf16_t* Bt; int M, N, K; };

struct StaticOrder {
    int nM, nN, nwg, G, c, rep;
    __host__ __device__ void init(int M, int N, int G_, int c_) { nM = M / BM; nN = N / BM; nwg = nM * nN; G = G_; c = c_; rep = 1; }
    __host__ __device__ bool next(int i, Unit& u) const {
        if (rep > 1) { const int cnt = (nwg - c + G - 1) / G; if (i >= cnt * rep) return false; i = i % cnt; }
        const long L = (long)i * G + c; if (L >= nwg) return false;
        int wgid = (int)L; { const int q = nwg / NXCD, r = nwg % NXCD, xcd = wgid % NXCD, off = wgid / NXCD; wgid = (xcd < r ? xcd * (q + 1) : r * (q + 1) + (xcd - r) * q) + off; }
        const int nig = WGM * nN, gid = wgid / nig, fm = gid * WGM, gsz = (nM - fm) < WGM ? (nM - fm) : WGM;
        u.pm = fm + ((wgid % nig) % gsz); u.pn = (wgid % nig) / gsz; return true;
    }
    __device__ __forceinline__ void a_ready(const Unit&) const {}
    __device__ __forceinline__ void done(const Unit&) const {}
};

__device__ __forceinline__ unsigned cvt_pk_bf16(float lo, float hi) { unsigned r; asm volatile("v_cvt_pk_bf16_f32 %0, %1, %2" : "=v"(r) : "v"(lo), "v"(hi)); return r; }
typedef float f32x2 __attribute__((ext_vector_type(2)));
__device__ __forceinline__ float sigmoid_fast(float x) { return __builtin_amdgcn_rcpf(1.0f + __builtin_amdgcn_exp2f(-1.4426950408889634f * x)); }
__device__ __forceinline__ u32x4 pack8(const f32x4 v0, const f32x4 v1) { u32x4 w; w.x = cvt_pk_bf16(v0[0], v0[1]); w.y = cvt_pk_bf16(v0[2], v0[3]); w.z = cvt_pk_bf16(v1[0], v1[1]); w.w = cvt_pk_bf16(v1[2], v1[3]); return w; }

struct EpiProj {
    static constexpr bool PERM = true, AFTER_DRAIN = false;
    bf16_t *Q, *K, *U;
    __device__ __forceinline__ void operator()(const f32x4 (&acc)[2][2][4][2], const Unit& u, int wr, int wc, int fr, int fq) const {
        const int row0 = u.pm * BM + wr * 64 + fr;
        if (u.pn < 8) {
            bf16_t* base = (u.pn < 4 ? Q : K) + (u.pn & 3) * 256 + wc * 32 + 8 * fq;
#pragma unroll
            for (int ai = 0; ai < 2; ++ai)
#pragma unroll
                for (int m = 0; m < 4; ++m) { bf16_t* rowp = base + (size_t)(row0 + ai * HALF + m * 16) * 1024;
#pragma unroll
                    for (int bj = 0; bj < 2; ++bj) *(u32x4*)(rowp + bj * HALF) = pack8(acc[ai][bj][m][0], acc[ai][bj][m][1]); }
        } else {
            bf16_t* base = U + (u.pn - 8) * 128 + wc * 32 + 8 * fq;
#pragma unroll
            for (int ai = 0; ai < 2; ++ai)
#pragma unroll
                for (int m = 0; m < 4; ++m) { bf16_t* rowp = base + (size_t)(row0 + ai * HALF + m * 16) * 1024;
                    f32x4 v[2];
#pragma unroll
                    for (int n = 0; n < 2; ++n) { const f32x4 a = acc[ai][0][m][n], g = acc[ai][1][m][n];
                        v[n] = (f32x4){a[0] * sigmoid_fast(g[0]), a[1] * sigmoid_fast(g[1]), a[2] * sigmoid_fast(g[2]), a[3] * sigmoid_fast(g[3])}; }
                    *(u32x4*)rowp = pack8(v[0], v[1]); }
        }
    }
};
struct EpiPlain {
    static constexpr bool PERM = true, AFTER_DRAIN = false;
    bf16_t* O; int ldc;
    __device__ __forceinline__ void operator()(const f32x4 (&acc)[2][2][4][2], const Unit& u, int wr, int wc, int fr, int fq) const {
        const int row0 = u.pm * BM + wr * 64 + fr; bf16_t* base = O + u.pn * BM + wc * 32 + 8 * fq;
#pragma unroll
        for (int ai = 0; ai < 2; ++ai)
#pragma unroll
            for (int m = 0; m < 4; ++m) { bf16_t* rowp = base + (size_t)(row0 + ai * HALF + m * 16) * ldc;
#pragma unroll
                for (int bj = 0; bj < 2; ++bj) *(u32x4*)(rowp + bj * HALF) = pack8(acc[ai][bj][m][0], acc[ai][bj][m][1]); }
    }
};
struct EpiSwiGLU {
    static constexpr bool PERM = true, AFTER_DRAIN = false;
    bf16_t* O; int ldc;
    __device__ __forceinline__ void operator()(const f32x4 (&acc)[2][2][4][2], const Unit& u, int wr, int wc, int fr, int fq) const {
        const int row0 = u.pm * BM + wr * 64 + fr; bf16_t* base = O + u.pn * 128 + wc * 32 + 8 * fq;
#pragma unroll
        for (int ai = 0; ai < 2; ++ai)
#pragma unroll
            for (int m = 0; m < 4; ++m) { bf16_t* rowp = base + (size_t)(row0 + ai * HALF + m * 16) * ldc;
                f32x4 v[2];
#pragma unroll
                for (int n = 0; n < 2; ++n) { const f32x4 a = acc[ai][0][m][n], b = acc[ai][1][m][n];
                    v[n] = (f32x4){a[0] * sigmoid_fast(a[0]) * b[0], a[1] * sigmoid_fast(a[1]) * b[1], a[2] * sigmoid_fast(a[2]) * b[2], a[3] * sigmoid_fast(a[3]) * b[3]}; }
                *(u32x4*)rowp = pack8(v[0], v[1]); }
    }
};
struct EpiSwiGLUN {
    static constexpr bool PERM = true, AFTER_DRAIN = false;
    bf16_t* O; int ldc; const float* rss;
    __device__ __forceinline__ void operator()(const f32x4 (&acc)[2][2][4][2], const Unit& u, int wr, int wc, int fr, int fq) const {
        const int row0 = u.pm * BM + wr * 64 + fr; bf16_t* base = O + u.pn * 128 + wc * 32 + 8 * fq;
#pragma unroll
        for (int ai = 0; ai < 2; ++ai)
#pragma unroll
            for (int m = 0; m < 4; ++m) { const int row = row0 + ai * HALF + m * 16; bf16_t* rowp = base + (size_t)row * ldc;
                const f32x4 p0 = *(const f32x4*)(rss + (size_t)row * 8), p1 = *(const f32x4*)(rss + (size_t)row * 8 + 4);
                const float rs = 1.0f / sqrtf((((p0[0] + p0[1]) + (p0[2] + p0[3])) + ((p1[0] + p1[1]) + (p1[2] + p1[3]))) * (1.0f / 2048.0f) + 1e-6f);
                f32x4 v[2];
#pragma unroll
                for (int n = 0; n < 2; ++n) { const f32x4 a = acc[ai][0][m][n] * rs, b = acc[ai][1][m][n] * rs;
                    v[n] = (f32x4){a[0] * sigmoid_fast(a[0]) * b[0], a[1] * sigmoid_fast(a[1]) * b[1], a[2] * sigmoid_fast(a[2]) * b[2], a[3] * sigmoid_fast(a[3]) * b[3]}; }
                *(u32x4*)rowp = pack8(v[0], v[1]); }
    }
};
struct EpiSwiGLUR {
    static constexpr bool PERM = true, AFTER_DRAIN = false;
    bf16_t* O; int ldc; const float* rsv;
    __device__ __forceinline__ void operator()(const f32x4 (&acc)[2][2][4][2], const Unit& u, int wr, int wc, int fr, int fq) const {
        const int row0 = u.pm * BM + wr * 64 + fr; bf16_t* base = O + u.pn * 128 + wc * 32 + 8 * fq;
        float rs8[8];
#pragma unroll
        for (int i = 0; i < 8; ++i) rs8[i] = rsv[row0 + (i >> 2) * HALF + (i & 3) * 16];
#pragma unroll
        for (int ai = 0; ai < 2; ++ai)
#pragma unroll
            for (int m = 0; m < 4; ++m) { const int row = row0 + ai * HALF + m * 16; bf16_t* rowp = base + (size_t)row * ldc; const float rs = rs8[ai * 4 + m];
                f32x4 v[2];
#pragma unroll
                for (int n = 0; n < 2; ++n) { const f32x4 a = acc[ai][0][m][n] * rs, b = acc[ai][1][m][n] * rs;
                    v[n] = (f32x4){a[0] * sigmoid_fast(a[0]) * b[0], a[1] * sigmoid_fast(a[1]) * b[1], a[2] * sigmoid_fast(a[2]) * b[2], a[3] * sigmoid_fast(a[3]) * b[3]}; }
                *(u32x4*)rowp = pack8(v[0], v[1]); }
    }
};
struct EpiResNorm {
    static constexpr bool PERM = false, AFTER_DRAIN = false;
    const float* base; float* out; bf16_t* hb; float* rss; int ldc; PG8_LAS float* red;
    __device__ __forceinline__ void operator()(const f32x4 (&acc)[2][2][4][2], const Unit& u, int wr, int wc, int fr, int fq) const {
        const int row0 = u.pm * BM + wr * 64 + fr, col0 = u.pn * BM + wc * 32 + 4 * fq;
#pragma unroll
        for (int ai = 0; ai < 2; ++ai)
#pragma unroll
            for (int m = 0; m < 4; ++m) { const int row = row0 + ai * HALF + m * 16; const size_t off = (size_t)row * ldc + col0; float ss = 0.f;
#pragma unroll
                for (int bj = 0; bj < 2; ++bj)
#pragma unroll
                    for (int n = 0; n < 2; ++n) { const f32x4 h = *(const f32x4*)(base + off + bj * HALF + n * 16) + acc[ai][bj][m][n];
                        *(f32x4*)(out + off + bj * HALF + n * 16) = h; ss += (h[0] * h[0] + h[1] * h[1]) + (h[2] * h[2] + h[3] * h[3]);
                        unsigned long long w = (unsigned long long)cvt_pk_bf16(h[0], h[1]) | ((unsigned long long)cvt_pk_bf16(h[2], h[3]) << 32);
                        *(unsigned long long*)(hb + off + bj * HALF + n * 16) = w; }
                ss += __shfl_xor(ss, 16); ss += __shfl_xor(ss, 32);
                if (fq == 0) red[(ai * HALF + wr * 64 + m * 16 + fr) * 4 + wc] = ss; }
        asm volatile("s_waitcnt lgkmcnt(0)" ::: "memory"); __builtin_amdgcn_s_barrier(); asm volatile("" ::: "memory");
        { const int t = threadIdx.x; if (t < 256) { const f32x4 p = *(const PG8_LAS f32x4*)(red + t * 4); rss[(size_t)(u.pm * BM + t) * 8 + u.pn] = (p[0] + p[1]) + (p[2] + p[3]); } }
        asm volatile("s_waitcnt lgkmcnt(0)" ::: "memory"); __builtin_amdgcn_s_barrier(); asm volatile("" ::: "memory");
    }
};
struct EpiRes {
    static constexpr bool PERM = false, AFTER_DRAIN = false;
    const float* base; float* out; int ldc;
    __device__ __forceinline__ void operator()(const f32x4 (&acc)[2][2][4][2], const Unit& u, int wr, int wc, int fr, int fq) const {
        const int row0 = u.pm * BM + wr * 64 + fr, col0 = u.pn * BM + wc * 32 + 4 * fq;
#pragma unroll
        for (int ai = 0; ai < 2; ++ai)
#pragma unroll
            for (int m = 0; m < 4; ++m) { const size_t off = (size_t)(row0 + ai * HALF + m * 16) * ldc + col0;
#pragma unroll
                for (int bj = 0; bj < 2; ++bj)
#pragma unroll
                    for (int n = 0; n < 2; ++n) { const f32x4 b = *(const f32x4*)(base + off + bj * HALF + n * 16); *(f32x4*)(out + off + bj * HALF + n * 16) = b + acc[ai][bj][m][n]; } }
    }
};
template <class Epi, class Sched, bool ALIGN_EPI = false, bool SP2 = false>
__device__ __forceinline__ void gemm_phase(PG8_LAS unsigned char* lds, const Gemm g, const Sched& S, const Epi& E) {
    const int tid = threadIdx.x, wid = __builtin_amdgcn_readfirstlane(tid >> 6), lane = tid & 63, wr = wid >> 2, wc = wid & 3, fr = lane & 15, fq = lane >> 4;
    const int K = g.K, nt = K / BK;
    unsigned voffA[2], voffB[2];
#pragma unroll
    for (int i = 0; i < 2; ++i) { int R, C; stage_rc(tid * 16 + i * 8192, R, C); const int Rb = Epi::PERM ? ((R & ~31) + perm32(R & 31)) : R;
        voffA[i] = (unsigned)(R * K + C) * 2u; voffB[i] = (unsigned)(Rb * K + C) * 2u; }
    const size_t kstep = (size_t)(BK * 2);
    const size_t hstep = (size_t)HALF * K * 2;
    const size_t tstep = 2 * hstep;
    const unsigned ldsw = (unsigned)wid * 1024u;
    const int aoff = lds_byte(wr * 64 + fr, fq * 8), boff = lds_byte(wc * 32 + fr, fq * 8);
#define PG8_SA(b, h) (((b) * 2 + (h)) * HTB)
#define PG8_SB(b, h) ((4 + (b) * 2 + (h)) * HTB)
#define PG8_STAGE(bufoff, gbase, voff) do { _Pragma("unroll") for (int _i = 0; _i < 2; ++_i) \
        __builtin_amdgcn_global_load_lds((const unsigned*)((const char*)(gbase) + (voff)[_i]), (PG8_LAS unsigned*)(lds + (bufoff) + ldsw + _i * 8192), 16, 0, 0); } while (0)
#define PG8_LDA(dst, b, h) do { _Pragma("unroll") for (int m = 0; m < 4; ++m) _Pragma("unroll") for (int k = 0; k < 2; ++k) dst[m][k] = *(const PG8_LAS bf16x8*)(lds + PG8_SA(b, h) + aoff + m * 2048 + k * 1024); } while (0)
#define PG8_LDB(dst, b, h) do { _Pragma("unroll") for (int n = 0; n < 2; ++n) _Pragma("unroll") for (int k = 0; k < 2; ++k) dst[n][k] = *(const PG8_LAS bf16x8*)(lds + PG8_SB(b, h) + boff + n * 2048 + k * 1024); } while (0)
#define PG8_MMA(ai, bj, At, Bt) do { __builtin_amdgcn_s_setprio(1); _Pragma("unroll") for (int m = 0; m < 4; ++m) _Pragma("unroll") for (int n = 0; n < 2; ++n) _Pragma("unroll") for (int k = 0; k < 2; ++k) \
        acc[ai][bj][m][n] = __builtin_amdgcn_mfma_f32_16x16x32_bf16(Bt[n][k], At[m][k], acc[ai][bj][m][n], 0, 0, 0); __builtin_amdgcn_s_setprio(0); } while (0)
#define PG8_WAIT_V(n) asm volatile("s_waitcnt vmcnt(" #n ")" ::: "memory")
#define PG8_WAIT_L(n) asm volatile("s_waitcnt lgkmcnt(" #n ")" ::: "memory")
#define PG8_BAR __builtin_amdgcn_s_barrier()
#define PG8_SCHED __builtin_amdgcn_sched_barrier(0)
    Unit cur, nxt; int ui = 0;
    if (!S.next(0, cur)) return;
    f32x4 acc[2][2][4][2];
#pragma unroll
    for (int a = 0; a < 2; ++a)
#pragma unroll
        for (int b = 0; b < 2; ++b)
#pragma unroll
            for (int m = 0; m < 4; ++m)
#pragma unroll
                for (int n = 0; n < 2; ++n) acc[a][b][m][n] = (f32x4){0.f, 0.f, 0.f, 0.f};
    bf16x8 At[4][2], B0[2][2], B1[2][2];
    const char* cA = (const char*)g.A + (size_t)cur.pm * tstep; const char* cB = (const char*)g.Bt + (size_t)cur.pn * tstep;
    S.a_ready(cur);
    if constexpr (SP2) {
        PG8_STAGE(PG8_SB(0, 0), cB, voffB); PG8_STAGE(PG8_SB(0, 1), cB + hstep, voffB); PG8_STAGE(PG8_SA(0, 0), cA, voffA); PG8_STAGE(PG8_SA(0, 1), cA + hstep, voffA);
        if (wr == 1) PG8_BAR;
        PG8_WAIT_V(2); PG8_BAR;
        PG8_STAGE(PG8_SB(1, 0), cB + kstep, voffB); PG8_STAGE(PG8_SA(1, 0), cA + kstep, voffA); PG8_STAGE(PG8_SB(1, 1), cB + hstep + kstep, voffB);
        PG8_WAIT_V(6); PG8_BAR;
    } else {
        PG8_STAGE(PG8_SB(0, 0), cB, voffB); PG8_STAGE(PG8_SA(0, 0), cA, voffA); PG8_STAGE(PG8_SB(0, 1), cB + hstep, voffB); PG8_STAGE(PG8_SA(0, 1), cA + hstep, voffA);
        if (wr == 1) PG8_BAR;
        PG8_WAIT_V(4); PG8_BAR;
        PG8_STAGE(PG8_SB(1, 0), cB + kstep, voffB); PG8_STAGE(PG8_SA(1, 0), cA + kstep, voffA); PG8_STAGE(PG8_SB(1, 1), cB + hstep + kstep, voffB);
        PG8_WAIT_V(6); PG8_BAR;
    }
    for (;;) {
        const bool has_next = S.next(ui + 1, nxt);
        const char* nA = has_next ? (const char*)g.A + (size_t)nxt.pm * tstep : cA; const char* nB = has_next ? (const char*)g.Bt + (size_t)nxt.pn * tstep : cB;
        for (int t = 0; t < nt; t += 2) {
            const bool last = (t == nt - 2);
            const char* a1 = cA + (size_t)(t + 1) * kstep;
            const char* a2 = last ? nA : cA + (size_t)(t + 2) * kstep; const char* b2 = last ? nB : cB + (size_t)(t + 2) * kstep;
            const char* a3 = a2 + kstep; const char* b3 = b2 + kstep;
            if (last && has_next) S.a_ready(nxt);
            if constexpr (SP2) {
            PG8_LDB(B0, 0, 0); PG8_LDB(B1, 0, 1); PG8_SCHED; PG8_LDA(At, 0, 0); PG8_STAGE(PG8_SA(1, 1), a1 + hstep, voffA);
            PG8_WAIT_V(8); PG8_WAIT_L(0); PG8_BAR; PG8_MMA(0, 0, At, B0); PG8_MMA(0, 1, At, B1); PG8_BAR; PG8_SCHED;
            PG8_LDA(At, 0, 1); PG8_STAGE(PG8_SB(0, 0), b2, voffB); PG8_STAGE(PG8_SB(0, 1), b2 + hstep, voffB); PG8_STAGE(PG8_SA(0, 0), a2, voffA);
            PG8_WAIT_V(8); PG8_WAIT_L(0); PG8_BAR; PG8_MMA(1, 0, At, B0); PG8_MMA(1, 1, At, B1); PG8_BAR; PG8_SCHED;
            PG8_LDB(B0, 1, 0); PG8_LDB(B1, 1, 1); PG8_SCHED; PG8_LDA(At, 1, 0); PG8_STAGE(PG8_SA(0, 1), a2 + hstep, voffA);
            PG8_WAIT_V(8); PG8_WAIT_L(0); PG8_BAR; PG8_MMA(0, 0, At, B0); PG8_MMA(0, 1, At, B1); PG8_BAR; PG8_SCHED;
            PG8_LDA(At, 1, 1); PG8_STAGE(PG8_SB(1, 0), b3, voffB); PG8_STAGE(PG8_SB(1, 1), b3 + hstep, voffB); PG8_STAGE(PG8_SA(1, 0), a3, voffA);
            PG8_WAIT_V(8); PG8_WAIT_L(0); PG8_BAR; PG8_MMA(1, 0, At, B0); PG8_MMA(1, 1, At, B1); PG8_BAR; PG8_SCHED;
            } else {
            PG8_LDB(B0, 0, 0); PG8_SCHED; PG8_LDA(At, 0, 0); PG8_STAGE(PG8_SA(1, 1), a1 + hstep, voffA);
            PG8_WAIT_L(8); PG8_BAR; PG8_WAIT_L(0); PG8_MMA(0, 0, At, B0); PG8_BAR; PG8_SCHED;
            PG8_LDB(B1, 0, 1); PG8_STAGE(PG8_SB(0, 0), b2, voffB);
            PG8_BAR; PG8_WAIT_L(0); PG8_MMA(0, 1, At, B1); PG8_BAR;
            PG8_LDA(At, 0, 1); PG8_STAGE(PG8_SA(0, 0), a2, voffA);
            PG8_BAR; PG8_WAIT_L(0); PG8_MMA(1, 0, At, B0); PG8_BAR; PG8_SCHED;
            PG8_STAGE(PG8_SB(0, 1), b2 + hstep, voffB);
            PG8_WAIT_V(6); PG8_BAR; PG8_MMA(1, 1, At, B1); PG8_BAR;
            PG8_LDB(B0, 1, 0); PG8_SCHED; PG8_LDA(At, 1, 0); PG8_STAGE(PG8_SA(0, 1), a2 + hstep, voffA);
            PG8_WAIT_L(8); PG8_BAR; PG8_WAIT_L(0); PG8_MMA(0, 0, At, B0); PG8_BAR; PG8_SCHED;
            PG8_LDB(B1, 1, 1); PG8_STAGE(PG8_SB(1, 0), b3, voffB);
            PG8_BAR; PG8_WAIT_L(0); PG8_MMA(0, 1, At, B1); PG8_BAR;
            PG8_LDA(At, 1, 1); PG8_STAGE(PG8_SA(1, 0), a3, voffA);
            PG8_BAR; PG8_WAIT_L(0); PG8_MMA(1, 0, At, B0); PG8_BAR; PG8_SCHED;
            PG8_STAGE(PG8_SB(1, 1), b3 + hstep, voffB);
            PG8_WAIT_V(6); PG8_BAR; PG8_MMA(1, 1, At, B1); PG8_BAR;
            }
        }
        if constexpr (ALIGN_EPI) { if (wr == 0) PG8_BAR; }
        if constexpr (!Epi::AFTER_DRAIN) { E(acc, cur, wr, wc, fr, fq); S.done(cur); }
        if (!has_next) break;
#pragma unroll
        for (int a = 0; a < 2; ++a)
#pragma unroll
            for (int b = 0; b < 2; ++b)
#pragma unroll
                for (int m = 0; m < 4; ++m)
#pragma unroll
                    for (int n = 0; n < 2; ++n) acc[a][b][m][n] = (f32x4){0.f, 0.f, 0.f, 0.f};
        cur = nxt; cA = nA; cB = nB; ++ui;
        if constexpr (ALIGN_EPI) { if (wr == 1) PG8_BAR; }
    }
    PG8_WAIT_V(0);
    if constexpr (!ALIGN_EPI) { if (wr == 0) PG8_BAR; }
    PG8_BAR;
    if constexpr (Epi::AFTER_DRAIN) { E.fused(acc, cur, wr, wc, fr, fq, lds, wid, lane); S.done(cur); }
#undef PG8_SA
#undef PG8_SB
#undef PG8_STAGE
#undef PG8_LDA
#undef PG8_LDB
#undef PG8_MMA
#undef PG8_WAIT_V
#undef PG8_WAIT_L
#undef PG8_BAR
#undef PG8_SCHED
}
}
constexpr int BATCH = 4, SEQ = 8192, DM = 2048, M_TOK = BATCH * SEQ;
constexpr int NHEAD = 4, HD = 128, VD = 256, ATT_W = 1024, CONV_CH = 1024, CONV_W = 31, IN_COLS = 5120, FFN = 5632;
constexpr float EPS_RMS = 1e-6f, EPS_LN = 1e-5f, LAMBDA_INIT = 0.2f;
constexpr float QSCALE = 0.08838834764831845f * 1.4426950408889634f;
constexpr int NTHREADS = 512, NWAVES = 8;

constexpr size_t MiB = 1u << 20;
constexpr size_t WS_COS = 1 * MiB, WS_SIN = 3 * MiB;
constexpr size_t WS_WIN = 8 * MiB;
constexpr size_t WS_WV = 24 * MiB;
constexpr size_t WS_WOUT = 28 * MiB;
constexpr size_t WS_WGU = 36 * MiB;
constexpr size_t WS_WDN = 80 * MiB;
constexpr size_t WS_XN = 104 * MiB;
constexpr size_t WS_Q = 232 * MiB, WS_K = 296 * MiB, WS_VT = 360 * MiB, WS_U = 424 * MiB, WS_MIX = 488 * MiB;
constexpr size_t WS_ACT = 232 * MiB;
constexpr size_t WS_END = 616 * MiB;

#define LAS __attribute__((address_space(3)))
typedef unsigned short bf16;
typedef unsigned v4u __attribute__((ext_vector_type(4)));
typedef unsigned v2u __attribute__((ext_vector_type(2)));
typedef float f32x4 __attribute__((ext_vector_type(4)));
typedef float f32x2 __attribute__((ext_vector_type(2)));
typedef short bf16x8 __attribute__((ext_vector_type(8)));
typedef float f32x16 __attribute__((ext_vector_type(16)));
constexpr int LDS_BYTES = 131072 + 4096 + 64;
constexpr int MISC_OFF = 131072, BARST_OFF = 131072 + 4096;
constexpr size_t WS_BAR = 0, BAR_ZERO_BYTES = 16384;

__device__ __forceinline__ unsigned f2bf(float f) { unsigned u = __builtin_bit_cast(unsigned, f); return (u + 0x7fffu + ((u >> 16) & 1u)) >> 16; }
__device__ __forceinline__ unsigned pk2(float lo, float hi) { return pg8::cvt_pk_bf16(lo, hi); }
__device__ __forceinline__ float bflo(unsigned w) { return __builtin_bit_cast(float, w << 16); }
__device__ __forceinline__ float bfhi(unsigned w) { return __builtin_bit_cast(float, w & 0xffff0000u); }
__device__ __forceinline__ float wave_sum(float v) {
#pragma unroll
    for (int o = 1; o < 64; o <<= 1) v += __shfl_xor(v, o);
    return v;
}
__device__ __forceinline__ float wave_max(float v) {
#pragma unroll
    for (int o = 1; o < 64; o <<= 1) v = fmaxf(v, __shfl_xor(v, o));
    return v;
}
#define LDS_WAIT() asm volatile("s_waitcnt lgkmcnt(0)" ::: "memory")

__device__ __forceinline__ void transpose_item(const float* W, int K, int N, int k0, int n0, bf16* dst, const float* kscale, LAS unsigned char* scr, int lane) {
    const int r = lane >> 4, c = lane & 15;
    f32x4 v[16];
#pragma unroll
    for (int j = 0; j < 8; ++j)
#pragma unroll
        for (int p = 0; p < 2; ++p) v[2 * j + p] = *(const f32x4*)(W + (size_t)(k0 + 8 * j + 2 * r + p) * N + n0 + 4 * c);
#pragma unroll
    for (int j = 0; j < 8; ++j) { const int k = 8 * j + 2 * r; float s0 = 1.0f, s1 = 1.0f; if (kscale) { const f32x2 sc = *(const f32x2*)(kscale + k0 + k); s0 = sc.x; s1 = sc.y; }
#pragma unroll
        for (int i = 0; i < 4; ++i) { const int n = 4 * c + i; *(LAS unsigned*)(scr + n * 128 + ((j ^ (c & 7)) << 4) + 4 * r) = pk2(v[2 * j][i] * s0, v[2 * j + 1][i] * s1); } }
    LDS_WAIT(); asm volatile("" ::: "memory");
    const int rr = lane >> 3, cc = lane & 7;
#pragma unroll
    for (int j = 0; j < 8; ++j) { const int n = 8 * j + rr; const v4u o = *(const LAS v4u*)(scr + n * 128 + ((cc ^ ((n >> 2) & 7)) << 4)); *(v4u*)(dst + (size_t)n * K + k0 + 8 * cc) = o; }
    LDS_WAIT(); asm volatile("" ::: "memory");
}
__device__ __forceinline__ void rms_load_gain(const float* g, f32x4 (&gg)[8], int lane) {
#pragma unroll
    for (int j = 0; j < 8; ++j) gg[j] = *(const f32x4*)(g + 256 * j + 8 * (lane & 31) + 4 * (lane >> 5));
}
__device__ __forceinline__ void rms_row_to_bf16(const float* xrow, const f32x4 (&gg)[8], bf16* orow, int lane) {
    const int lo = lane & 31, hi = lane >> 5;
    const f32x4* xr = (const f32x4*)xrow + 2 * lo + hi;
    f32x4 v[8]; float s = 0.f;
#pragma unroll
    for (int j = 0; j < 8; ++j) { v[j] = xr[64 * j]; s += (v[j].x * v[j].x + v[j].y * v[j].y) + (v[j].z * v[j].z + v[j].w * v[j].w); }
    const float rinv = 1.0f / sqrtf(wave_sum(s) * (1.f / DM) + EPS_RMS);
#pragma unroll
    for (int i = 0; i < 4; ++i) { v2u wa, wb;
        { const f32x4 x = v[2 * i], g = gg[2 * i]; wa.x = pk2(x.x * rinv * g.x, x.y * rinv * g.y); wa.y = pk2(x.z * rinv * g.z, x.w * rinv * g.w); }
        { const f32x4 x = v[2 * i + 1], g = gg[2 * i + 1]; wb.x = pk2(x.x * rinv * g.x, x.y * rinv * g.y); wb.y = pk2(x.z * rinv * g.z, x.w * rinv * g.w); }
        const auto rx = __builtin_amdgcn_permlane32_swap(wa.x, wb.x, false, false);
        const auto ry = __builtin_amdgcn_permlane32_swap(wa.y, wb.y, false, false);
        v4u w16; w16.x = rx[0]; w16.y = ry[0]; w16.z = rx[1]; w16.w = ry[1];
        *(v4u*)(orow + 256 * (2 * i + hi) + 8 * lo) = w16; }
}

struct Ptrs {
    const float *x, *norm1_g, *w_in, *q_norm_g, *k_norm_g, *lq1, *lk1, *lq2, *lk2, *subln_g, *conv_w, *conv_b, *conv_ln_g, *conv_ln_b, *w_out, *norm2_g, *w_gate, *w_up, *w_down;
    float* out;
    bf16 *Wt_in, *Wt_v, *Wt_out, *Wt_gu, *Wt_dn, *XN, *Q, *K, *VT, *U, *MIX, *ACT;
    float *COS, *SIN;
};

__device__ __forceinline__ void p0_prologue(const Ptrs& P, LAS unsigned char* lds, int gw, int NGW, int wave, int lane) {
    LAS unsigned char* scr = lds + wave * 16384;
    constexpr int I_IN = 32 * 80, I_OUT = 32 * 32, I_G = 32 * 88, I_D = 88 * 32;
    constexpr int NITEMS = I_IN + I_OUT + 2 * I_G + I_D;
    for (int it = gw; it < NITEMS; it += NGW) {
        int r = it;
        if (r < I_IN) { const int kb = r / 80, n0 = (r % 80) * 64; bf16* dst;
            if (n0 < 2048) dst = P.Wt_in + (size_t)n0 * DM;
            else if (n0 < 3072) dst = P.Wt_v + (size_t)(n0 - 2048) * DM;
            else if (n0 < 4096) { const int ch = n0 - 3072; dst = P.Wt_in + (size_t)(2048 + (ch >> 7) * 256 + (ch & 127)) * DM; }
            else { const int ch = n0 - 4096; dst = P.Wt_in + (size_t)(2048 + (ch >> 7) * 256 + 128 + (ch & 127)) * DM; }
            transpose_item(P.w_in, DM, IN_COLS, kb * 64, n0, dst, nullptr, scr, lane); continue; }
        r -= I_IN;
        if (r < I_OUT) { const int kb = r / 32, n0 = (r % 32) * 64; transpose_item(P.w_out, DM, DM, kb * 64, n0, P.Wt_out + (size_t)n0 * DM, nullptr, scr, lane); continue; }
        r -= I_OUT;
        if (r < I_G) { const int kb = r / 88, n0 = (r % 88) * 64; transpose_item(P.w_gate, DM, FFN, kb * 64, n0, P.Wt_gu + (size_t)((n0 >> 7) * 256 + (n0 & 127)) * DM, nullptr, scr, lane); continue; }
        r -= I_G;
        if (r < I_G) { const int kb = r / 88, n0 = (r % 88) * 64; transpose_item(P.w_up, DM, FFN, kb * 64, n0, P.Wt_gu + (size_t)((n0 >> 7) * 256 + 128 + (n0 & 127)) * DM, nullptr, scr, lane); continue; }
        r -= I_G;
        { const int kb = r / 32, n0 = (r % 32) * 64; transpose_item(P.w_down, FFN, DM, kb * 64, n0, P.Wt_dn + (size_t)n0 * FFN, nullptr, scr, lane); }
    }
    { f32x4 gg[8]; rms_load_gain(P.norm1_g, gg, lane);
      for (int m = gw; m < M_TOK; m += NGW) rms_row_to_bf16(P.x + (size_t)m * DM, gg, P.XN + (size_t)m * DM, lane); }
    for (int i = gw * 64 + lane; i < SEQ * 64; i += NGW * 64) {
        const int pos = i >> 6, j = i & 63;
        const float inv = (float)exp2(-(double)j * (13.287712379549449 / 64.0));
        const float ang = (float)pos * inv;
        double rev = (double)ang * 0.15915494309189535; rev -= rint(rev);
        const float fr = (float)rev;
        P.COS[i] = __builtin_amdgcn_cosf(fr); P.SIN[i] = __builtin_amdgcn_sinf(fr);
    }
}

__device__ __forceinline__ void p2_qk_norm_rope(const Ptrs& P, int gw, int NGW, int lane) {
    const int sub = lane & 7, grp = lane >> 3;
    f32x4 gq[4], gk[4];
#pragma unroll
    for (int i = 0; i < 4; ++i) { const int o = sub * 8 + (i & 1) * 4 + (i >> 1) * 64; gq[i] = *(const f32x4*)(P.q_norm_g + o); gk[i] = *(const f32x4*)(P.k_norm_g + o); }
    for (int row = gw; row < M_TOK; row += NGW) {
        bf16* pq = P.Q + (size_t)row * 1024 + grp * 128 + sub * 8; bf16* pk = P.K + (size_t)row * 1024 + grp * 128 + sub * 8;
        const v4u q1 = *(const v4u*)pq, q2 = *(const v4u*)(pq + 64), k1 = *(const v4u*)pk, k2 = *(const v4u*)(pk + 64);
        const int pos = row & (SEQ - 1);
        const f32x4 c0 = *(const f32x4*)(P.COS + pos * 64 + sub * 8), c1 = *(const f32x4*)(P.COS + pos * 64 + sub * 8 + 4);
        const f32x4 s0 = *(const f32x4*)(P.SIN + pos * 64 + sub * 8), s1 = *(const f32x4*)(P.SIN + pos * 64 + sub * 8 + 4);
#pragma unroll
        for (int which = 0; which < 2; ++which) {
            const v4u r1 = which ? k1 : q1, r2 = which ? k2 : q2;
            float t1[8], t2[8];
#pragma unroll
            for (int j = 0; j < 4; ++j) { t1[2 * j] = bflo(r1[j]); t1[2 * j + 1] = bfhi(r1[j]); t2[2 * j] = bflo(r2[j]); t2[2 * j + 1] = bfhi(r2[j]); }
            float ss = 0.f;
#pragma unroll
            for (int j = 0; j < 8; ++j) ss += t1[j] * t1[j] + t2[j] * t2[j];
            ss += __shfl_xor(ss, 1); ss += __shfl_xor(ss, 2); ss += __shfl_xor(ss, 4);
            const float rinv = (1.0f / sqrtf(ss * (1.f / HD) + EPS_RMS)) * (which ? 1.0f : QSCALE);
            float o1[8], o2[8];
#pragma unroll
            for (int j = 0; j < 8; ++j) {
                const float cc = j < 4 ? c0[j & 3] : c1[j & 3], sn = j < 4 ? s0[j & 3] : s1[j & 3];
                const float ga = which ? (j < 4 ? gk[0][j & 3] : gk[1][j & 3]) : (j < 4 ? gq[0][j & 3] : gq[1][j & 3]);
                const float gb = which ? (j < 4 ? gk[2][j & 3] : gk[3][j & 3]) : (j < 4 ? gq[2][j & 3] : gq[3][j & 3]);
                const float n1 = t1[j] * rinv * ga, n2 = t2[j] * rinv * gb;
                o1[j] = n1 * cc - n2 * sn; o2[j] = n2 * cc + n1 * sn;
            }
            v4u w1, w2;
#pragma unroll
            for (int j = 0; j < 4; ++j) { w1[j] = pk2(o1[2 * j], o1[2 * j + 1]); w2[j] = pk2(o2[2 * j], o2[2 * j + 1]); }
            bf16* p = which ? pk : pq;
            *(v4u*)p = w1; *(v4u*)(p + 64) = w2;
        }
    }
}

__device__ __forceinline__ void glds16c(const void* sbase, unsigned voff, unsigned lds_dst) {
    unsigned keep;
    asm volatile("s_mov_b32 %0, m0\n\ts_mov_b32 m0, %3\n\ts_nop 0\n\tglobal_load_lds_dwordx4 %1, %2\n\ts_mov_b32 m0, %0" : "=&s"(keep) : "v"(voff), "s"(sbase), "s"(lds_dst) : "memory");
}
#define CBAR() do { LDS_WAIT(); asm volatile("" ::: "memory"); __builtin_amdgcn_s_barrier(); asm volatile("" ::: "memory"); } while (0)
#define CONV_ISSUE(item_) do { const int row0_ = (item_) * 16, s0_ = row0_ & (SEQ - 1); \
        _Pragma("nounroll") for (int k_ = 0; k_ < 12; ++k_) { const int p_ = wave + 8 * k_; if (p_ < 92) { const int r_ = p_ >> 1; const int rr_ = (s0_ - 30 + r_ < 0) ? 30 : r_; \
            glds16c((const char*)P.U + ((size_t)(row0_ - 30 + rr_) * 2048 + (size_t)(p_ & 1) * 1024), (unsigned)lane * 16u, lds0 + (unsigned)p_ * 1024u); } } } while (0)
__device__ __forceinline__ void p3_conv(const Ptrs& P, LAS unsigned char* lds, int first, int stride, int tid, int wave, int lane) {
    const int ch = 2 * tid;
    constexpr int NITEMS = M_TOK / 16, OT_OFF = 94208;
    f32x2 w[CONV_W];
#pragma unroll
    for (int k = 0; k < CONV_W; ++k) w[k] = *(const f32x2*)(P.conv_w + k * CONV_CH + ch);
    const f32x2 cb = *(const f32x2*)(P.conv_b + ch), lg = *(const f32x2*)(P.conv_ln_g + ch), lb = *(const f32x2*)(P.conv_ln_b + ch);
    LAS float* red = (LAS float*)(lds + MISC_OFF);
    LAS float* stat = red + 256;
    int bpi[6];
#pragma unroll
    for (int k = 0; k < 6; ++k) bpi[k] = (lane ^ (1 << k)) << 2;
    const unsigned lds0 = (unsigned)__builtin_amdgcn_readfirstlane((int)(unsigned)(uintptr_t)lds);
    asm volatile("s_waitcnt vmcnt(0)" ::: "memory");
#pragma unroll
    for (int k = 0; k < CONV_W; ++k) asm volatile("" : "+v"(w[k]));
    if (first < NITEMS) CONV_ISSUE(first);
    for (int item = first; item < NITEMS; item += stride) {
        const int row0 = item * 16, s0 = row0 & (SEQ - 1);
        asm volatile("s_waitcnt vmcnt(0)" ::: "memory");
        CBAR();
        unsigned uv[46];
#pragma unroll
        for (int r = 0; r < 46; ++r) { const int neg = (s0 - 30 + r) >> 31;
            uv[r] = *(const LAS unsigned*)(lds + r * 2048 + tid * 4) & ~(unsigned)neg; }
        CBAR();
        if (item + stride < NITEMS) CONV_ISSUE(item + stride);
        f32x2 a[16];
#pragma unroll
        for (int t = 0; t < 16; ++t) a[t] = cb;
#pragma unroll
        for (int r = 0; r < 46; ++r) {
            const f32x2 u = (f32x2){bflo(uv[r]), bfhi(uv[r])};
#pragma unroll
            for (int t = 0; t < 16; ++t) { const int k = r - t; if (k >= 0 && k < CONV_W) a[t] += u * w[k]; }
        }
#pragma unroll
        for (int t = 0; t < 16; ++t) {
            float s1 = a[t].x + a[t].y, s2 = a[t].x * a[t].x + a[t].y * a[t].y;
#pragma unroll
            for (int k = 0; k < 6; ++k) {
                s1 += __builtin_bit_cast(float, __builtin_amdgcn_ds_bpermute(bpi[k], __builtin_bit_cast(int, s1)));
                s2 += __builtin_bit_cast(float, __builtin_amdgcn_ds_bpermute(bpi[k], __builtin_bit_cast(int, s2)));
            }
            if (lane == 0) { red[(wave * 16 + t) * 2] = s1; red[(wave * 16 + t) * 2 + 1] = s2; }
        }
        CBAR();
        if (tid < 16) { float s1 = 0.f, s2 = 0.f;
#pragma unroll
            for (int ww = 0; ww < 8; ++ww) { s1 += red[(ww * 16 + tid) * 2]; s2 += red[(ww * 16 + tid) * 2 + 1]; }
            const float mu = s1 * (1.f / CONV_CH), var = fmaxf(s2 * (1.f / CONV_CH) - mu * mu, 0.f);
            stat[tid * 2] = mu; stat[tid * 2 + 1] = 1.0f / sqrtf(var + EPS_LN); }
        CBAR();
#pragma unroll
        for (int t = 0; t < 16; ++t) {
            const float mu = stat[t * 2], rs = stat[t * 2 + 1];
            const float y0 = (a[t].x - mu) * rs * lg.x + lb.x, y1 = (a[t].y - mu) * rs * lg.y + lb.y;
            *(LAS unsigned*)(lds + OT_OFF + t * 2048 + tid * 4) = pk2(y0 * pg8::sigmoid_fast(y0), y1 * pg8::sigmoid_fast(y1));
        }
        CBAR();
#pragma unroll
        for (int k = 0; k < 4; ++k) { const int c = tid + 512 * k; const v4u v = *(const LAS v4u*)(lds + OT_OFF + c * 16);
            *(v4u*)((char*)P.MIX + ((size_t)(row0 + (c >> 7)) * DM + ATT_W) * 2 + (size_t)(c & 127) * 16) = v; }
        CBAR();
    }
    asm volatile("s_waitcnt vmcnt(0)" ::: "memory");
}
#undef CONV_ISSUE
#undef CBAR

namespace att {
constexpr int BUF = 65536, V_OFF = 32768;
__device__ __forceinline__ void glds16(const void* sbase, unsigned voff, unsigned lds_dst) {
    unsigned keep;
    asm volatile("s_mov_b32 %0, m0\n\ts_mov_b32 m0, %3\n\ts_nop 0\n\tglobal_load_lds_dwordx4 %1, %2\n\ts_mov_b32 m0, %0" : "=&s"(keep) : "v"(voff), "s"(sbase), "s"(lds_dst) : "memory");
}
__device__ __forceinline__ int pi32(int i) { return (i & ~12) | ((i & 4) << 1) | ((i & 8) >> 1); }
#define ATT_WAIT_V(n) asm volatile("s_waitcnt vmcnt(" #n ")" ::: "memory")
#define ATT_BAR() do { asm volatile("" ::: "memory"); __builtin_amdgcn_s_barrier(); asm volatile("" ::: "memory"); } while (0)

__device__ __forceinline__ void attn_block(LAS unsigned char* lds, const Ptrs& P, int b, int h, int qb, float negMb, float lam, int tid, int wid, int lane) {
    const int comp = wid & 1, quarter = wid >> 1, l31 = lane & 31, hh = lane >> 5;
    const int NT = 2 * qb + 2;
    const size_t tok0 = (size_t)b * SEQ;
    const int qpos = qb * 128 + quarter * 32 + l31;
    bf16x8 qf[8];
    { const bf16* qp = P.Q + (tok0 + qpos) * 1024 + h * 256 + comp * 128 + hh * 8;
#pragma unroll
      for (int ks = 0; ks < 8; ++ks) qf[ks] = *(const bf16x8*)(qp + ks * 16); }
    const unsigned ldsw = (unsigned)wid * 4096u;
    const unsigned lds0 = (unsigned)__builtin_amdgcn_readfirstlane((int)(unsigned)(uintptr_t)lds);
    unsigned kb0, kx16, vb0, vy16;
    { int ln_ = lane; asm volatile("" : "+v"(ln_));
      kb0 = (unsigned)(((16 * (wid & 3) + (ln_ >> 4)) * 1024 + h * 256 + (wid >> 2) * 128) * 2); kx16 = (unsigned)(((ln_ & 15) ^ (ln_ >> 4)) << 4);
      vb0 = (unsigned)(((h * 256 + 32 * wid + (ln_ >> 3)) * M_TOK) * 2); vy16 = (unsigned)(((ln_ & 7) ^ (ln_ >> 4)) << 4);
      asm volatile("" : "+v"(kb0), "+v"(kx16), "+v"(vb0), "+v"(vy16)); }
#define ATT_DMA(t, bufi) do { const char* kb_ = (const char*)P.K + (tok0 + (size_t)(t) * 64) * 2048; const char* vb_ = (const char*)P.VT + (tok0 + (size_t)(t) * 64) * 2; \
        _Pragma("unroll") for (int pp = 0; pp < 4; ++pp) glds16(kb_, kb0 + pp * 8192 + (kx16 ^ (64 * pp)), lds0 + (bufi) * BUF + ldsw + pp * 1024); \
        _Pragma("unroll") for (int pp = 0; pp < 4; ++pp) glds16(vb_, vb0 + pp * (8 * M_TOK * 2) + (vy16 ^ (64 * (pp & 1))), lds0 + (bufi) * BUF + V_OFF + ldsw + pp * 1024); } while (0)
    f32x16 o[8];
#pragma unroll
    for (int e = 0; e < 8; ++e)
#pragma unroll
        for (int r = 0; r < 16; ++r) o[e][r] = 0.f;
    float lsum = 0.f;
    ATT_WAIT_V(0);
#pragma unroll
    for (int ks = 0; ks < 8; ++ks) asm volatile("" : "+v"(qf[ks]));
    ATT_DMA(0, 0);
    const bool early = wid < 4;
    for (int t = 0; t < NT; ++t) {
        ATT_WAIT_V(0);
        LDS_WAIT();
        ATT_BAR();
        const bool more = t + 1 < NT;
        if (more && early) ATT_DMA(t + 1, (t + 1) & 1);
        const bool active = (quarter >= 2) || more;
        const LAS unsigned char* base = lds + (t & 1) * BUF;
        int ln2 = lane; asm volatile("" : "+v"(ln2));
        const int l31b = ln2 & 31, hhb = ln2 >> 5;
        const int krow = pi32(l31b), kx = krow & 15;
        const int koffr = comp * 16384 + krow * 256;
        const int vx = (l31b >> 1) & 7;
        const int voffr = V_OFF + l31b * 128;
#pragma unroll
        for (int T = 0; T < 2; ++T) {
            if (T == 1 && more && !early) ATT_DMA(t + 1, (t + 1) & 1);
            if (active) {
                f32x16 s;
#pragma unroll
                for (int r = 0; r < 16; ++r) s[r] = negMb;
#pragma unroll
                for (int ks = 0; ks < 8; ++ks) {
                    const bf16x8 kf = *(const LAS bf16x8*)(base + koffr + T * 8192 + (((2 * ks + hhb) ^ kx) << 4));
                    s = __builtin_amdgcn_mfma_f32_32x32x16_bf16(kf, qf[ks], s, 0, 0, 0);
                }
                float ps = 0.f;
#pragma unroll
                for (int r = 0; r < 16; ++r) { s[r] = __builtin_amdgcn_exp2f(s[r]); ps += s[r]; }
                lsum += ps;
#pragma unroll
                for (int sI = 0; sI < 2; ++sI) { v4u w;
#pragma unroll
                    for (int j = 0; j < 4; ++j) w[j] = pk2(s[8 * sI + 2 * j], s[8 * sI + 2 * j + 1]);
                    const bf16x8 pf = __builtin_bit_cast(bf16x8, w);
                    const LAS unsigned char* vb = base + voffr + (((2 * (2 * T + sI) + hhb) ^ vx) << 4);
#pragma unroll
                    for (int e = 0; e < 8; ++e) {
                        const bf16x8 vf = *(const LAS bf16x8*)(vb + e * 4096);
                        o[e] = __builtin_amdgcn_mfma_f32_32x32x16_bf16(vf, pf, o[e], 0, 0, 0);
                    }
                }
            }
        }
    }
    LDS_WAIT();
    ATT_BAR();
    const float ltot = lsum + __shfl_xor(lsum, 32);
    const float inv = 1.0f / ltot;
    int ln3 = lane; asm volatile("" : "+v"(ln3));
    const int hh3 = ln3 >> 5, qpos3 = qb * 128 + quarter * 32 + (ln3 & 31);
    LAS unsigned char* xb = lds + quarter * 32768 + ln3 * 16;
    if (comp == 1) {
        const float sc = lam * inv;
#pragma unroll
        for (int e = 0; e < 8; ++e)
#pragma unroll
            for (int r4 = 0; r4 < 4; ++r4) *(LAS f32x4*)(xb + (e * 4 + r4) * 1024) = (f32x4){o[e][4 * r4] * sc, o[e][4 * r4 + 1] * sc, o[e][4 * r4 + 2] * sc, o[e][4 * r4 + 3] * sc};
    }
    LDS_WAIT();
    ATT_BAR();
    if (comp == 0) {
        float ss = 0.f;
#pragma unroll
        for (int e = 0; e < 8; ++e)
#pragma unroll
            for (int r4 = 0; r4 < 4; ++r4) { const f32x4 x1 = *(const LAS f32x4*)(xb + (e * 4 + r4) * 1024);
#pragma unroll
                for (int i = 0; i < 4; ++i) { const float v = o[e][4 * r4 + i] * inv - x1[i]; o[e][4 * r4 + i] = v; ss += v * v; } }
        ss += __shfl_xor(ss, 32);
        const float rn = (1.0f / sqrtf(ss * (1.f / VD) + EPS_RMS)) * (1.0f - LAMBDA_INIT);
        bf16* orow = P.MIX + (tok0 + qpos3) * DM + h * 256 + 8 * hh3;
        const LAS float* gp = (const LAS float*)(lds + MISC_OFF + 3072) + 4 * hh3;
#pragma unroll
        for (int e = 0; e < 8; ++e)
#pragma unroll
            for (int i2 = 0; i2 < 2; ++i2) { v2u wab[2];
#pragma unroll
                for (int q = 0; q < 2; ++q) { const int r4 = 2 * i2 + q; const f32x4 g = *(const LAS f32x4*)(gp + 32 * e + 8 * r4);
                    wab[q].x = pk2(o[e][4 * r4] * rn * g[0], o[e][4 * r4 + 1] * rn * g[1]); wab[q].y = pk2(o[e][4 * r4 + 2] * rn * g[2], o[e][4 * r4 + 3] * rn * g[3]); }
                const auto rx = __builtin_amdgcn_permlane32_swap(wab[0].x, wab[1].x, false, false);
                const auto ry = __builtin_amdgcn_permlane32_swap(wab[0].y, wab[1].y, false, false);
                v4u w16; w16.x = rx[0]; w16.y = ry[0]; w16.z = rx[1]; w16.w = ry[1];
                *(v4u*)(orow + 32 * e + 16 * i2) = w16; }
    }
    LDS_WAIT();
    ATT_BAR();
#undef ATT_DMA
}
}

#define XB_TMO      128
#define XB_XCNT(j)  (256  + 64 * (j))
#define XB_XSUB(j)  (1280 + 64 * (j))
#define XB_XGEN(j)  (2304 + 64 * (j))
#define XB_TOP      3328
#define XB_TOPGEN   3392
#define XCD_BAR_WORDS 3456
#define XB_SPIN_CAP (1u << 18)

__device__ __forceinline__ unsigned xb_ld(unsigned* p)              { return __hip_atomic_load(p, __ATOMIC_RELAXED, __HIP_MEMORY_SCOPE_AGENT); }
__device__ __forceinline__ unsigned xb_add(unsigned* p, unsigned v) { return __hip_atomic_fetch_add(p, v, __ATOMIC_RELAXED, __HIP_MEMORY_SCOPE_AGENT); }
__device__ __forceinline__ unsigned xb_xcc_id() { return (unsigned)__builtin_amdgcn_s_getreg((3 << 11) | 20) & 0xFu; }
#define XB_SPIN(cond, bar) do { unsigned _sp = 0; while (cond) { __builtin_amdgcn_s_sleep(1); \
    if ((++_sp & 255u) == 0u) { if (xb_ld(&(bar)[XB_TMO])) break; if (_sp > XB_SPIN_CAP) { atomicAdd(&(bar)[XB_TMO], 1u); break; } } } } while (0)

struct XcdBarrier {
    unsigned* bar; unsigned x;
    volatile LAS unsigned* st;
};

__device__ __forceinline__ XcdBarrier xcd_barrier_post(unsigned* bar, volatile LAS unsigned* st) {
    XcdBarrier b; b.bar = bar; b.x = xb_xcc_id(); b.st = st;
    if (threadIdx.x == 0) (void)xb_add(&bar[XB_XCNT(b.x)], 1u);
    return b;
}
__device__ __forceinline__ void xcd_barrier_complete(unsigned* bar, unsigned x, unsigned& nloc, unsigned& nx) {
    const unsigned G = gridDim.x * gridDim.y * gridDim.z;
    unsigned sum, cnt, mine, sp = 0u;
    for (;;) {
        sum = 0u; cnt = 0u; mine = 0u;
#pragma unroll
        for (unsigned j = 0; j < 16; ++j) { const unsigned c = xb_ld(&bar[XB_XCNT(j)]); sum += c; cnt += (c > 0u) ? 1u : 0u; mine = (j == x) ? c : mine; }
        if (sum == G) break;
        __builtin_amdgcn_s_sleep(1);
        if ((++sp & 255u) == 0u) { if (xb_ld(&bar[XB_TMO])) break; if (sp > XB_SPIN_CAP) { atomicAdd(&bar[XB_TMO], 1u); break; } }
    }
    nloc = mine > 0u ? mine : 1u; nx = cnt > 0u ? cnt : 1u;
}

__device__ __forceinline__ void xcd_barrier(const XcdBarrier& b) {
    asm volatile("s_waitcnt vmcnt(0)" ::: "memory");
    __syncthreads();
    if (threadIdx.x == 0) {
        unsigned* bar = b.bar;
        __builtin_amdgcn_s_waitcnt(0);
        unsigned nloc = b.st[0], nx = b.st[1];
        if (nloc == 0u) { xcd_barrier_complete(bar, b.x, nloc, nx); b.st[0] = nloc; b.st[1] = nx; }
        const unsigned old = xb_add(&bar[XB_XSUB(b.x)], 1u);
        const unsigned gen = old / nloc;
        if (old + 1u == (gen + 1u) * nloc) {
            __builtin_amdgcn_fence(__ATOMIC_RELEASE, "agent");
            asm volatile("s_waitcnt vmcnt(0)" ::: "memory");
            const unsigned og = xb_add(&bar[XB_TOP], 1u);
            const unsigned tg = og / nx;
            if (og + 1u == (tg + 1u) * nx) xb_add(&bar[XB_TOPGEN], 1u);
            else XB_SPIN(xb_ld(&bar[XB_TOPGEN]) == tg, bar);
            __builtin_amdgcn_fence(__ATOMIC_ACQUIRE, "agent");
            xb_add(&bar[XB_XGEN(b.x)], 1u);
            asm volatile("s_waitcnt vmcnt(0)" ::: "memory");
        } else {
            XB_SPIN(xb_ld(&bar[XB_XGEN(b.x)]) == gen, bar);
            __builtin_amdgcn_fence(__ATOMIC_ACQUIRE, "agent");
            asm volatile("s_waitcnt vmcnt(0)" ::: "memory");
        }
    }
    __syncthreads();
}

struct Args { const float* in[19]; float* out; unsigned char* ws; int ph_lo, ph_hi; };
constexpr int N_PHASES = 8;

__global__ void __launch_bounds__(NTHREADS) mega_fwd(Args args) {
    extern __shared__ __attribute__((aligned(16))) unsigned char lds_raw[];
    LAS unsigned char* lds = (LAS unsigned char*)lds_raw;
    const int tid = threadIdx.x, lane = tid & 63, wave = __builtin_amdgcn_readfirstlane(tid >> 6);
    const int G = gridDim.x, bx = blockIdx.x;
    const int vcu = (G % 8 == 0) ? (bx % 8) * (G / 8) + bx / 8 : bx;
    const int gw = vcu * NWAVES + wave, NGW = G * NWAVES;
    unsigned char* ws = args.ws;
#define MAKE_P() Ptrs P; { unsigned char* w_ = args.ws; asm volatile("" : "+s"(w_)); \
    P.x = args.in[0]; P.norm1_g = args.in[1]; P.w_in = args.in[2]; P.q_norm_g = args.in[3]; P.k_norm_g = args.in[4]; P.lq1 = args.in[5]; P.lk1 = args.in[6]; P.lq2 = args.in[7]; P.lk2 = args.in[8]; \
    P.subln_g = args.in[9]; P.conv_w = args.in[10]; P.conv_b = args.in[11]; P.conv_ln_g = args.in[12]; P.conv_ln_b = args.in[13]; P.w_out = args.in[14]; P.norm2_g = args.in[15]; \
    P.w_gate = args.in[16]; P.w_up = args.in[17]; P.w_down = args.in[18]; P.out = args.out; \
    P.Wt_in = (bf16*)(w_ + WS_WIN); P.Wt_v = (bf16*)(w_ + WS_WV); P.Wt_out = (bf16*)(w_ + WS_WOUT); P.Wt_gu = (bf16*)(w_ + WS_WGU); P.Wt_dn = (bf16*)(w_ + WS_WDN); \
    P.XN = (bf16*)(w_ + WS_XN); P.Q = (bf16*)(w_ + WS_Q); P.K = (bf16*)(w_ + WS_K); P.VT = (bf16*)(w_ + WS_VT); P.U = (bf16*)(w_ + WS_U); P.MIX = (bf16*)(w_ + WS_MIX); P.ACT = (bf16*)(w_ + WS_ACT); \
    P.COS = (float*)(w_ + WS_COS); P.SIN = (float*)(w_ + WS_SIN); }
    const int lo = args.ph_lo, hi = args.ph_hi;
    if (tid < 2) ((volatile LAS unsigned*)(lds + BARST_OFF))[tid] = 0u;
    __syncthreads();
    XcdBarrier gbar = xcd_barrier_post((unsigned*)(ws + WS_BAR), (volatile LAS unsigned*)(lds + BARST_OFF));
#ifndef PHASE_MASK
#define PHASE_MASK 0xff
#endif
#define IN(k) (((PHASE_MASK >> (k)) & 1) && lo <= (k) && (k) < hi)
#ifndef REP3
#define REP3 1
#endif
#ifndef REP6
#define REP6 1
#endif
#ifndef REP1
#define REP1 1
#endif
#define SEAM(k) do { if (IN(k) && IN((k) + 1)) { if (args.ph_hi > 1000) cooperative_groups::this_grid().sync(); else xcd_barrier(gbar); } } while (0)

    if (IN(0)) { MAKE_P(); p0_prologue(P, lds, gw, NGW, wave, lane); }
    SEAM(0);
    if (IN(1)) {
        MAKE_P();
        { pg8::Gemm g{P.XN, P.Wt_in, M_TOK, 4096, DM}; pg8::StaticOrder S; S.init(M_TOK, 4096, G, bx); S.rep = REP1; pg8::EpiProj E{P.Q, P.K, P.U};
          pg8::gemm_phase<pg8::EpiProj, pg8::StaticOrder, true, true>(lds, g, S, E); }
        { pg8::Gemm g{P.Wt_v, P.XN, 1024, M_TOK, DM}; pg8::StaticOrder S; S.init(1024, M_TOK, G, bx); pg8::EpiPlain E{P.VT, M_TOK};
          pg8::gemm_phase<pg8::EpiPlain, pg8::StaticOrder, true, true>(lds, g, S, E); }
    }
    SEAM(1);
    if (IN(2)) { MAKE_P(); p2_qk_norm_rope(P, gw, NGW, lane); }
    SEAM(2);
    if (IN(3)) {
        MAKE_P();
#ifndef NO_CONV
        p3_conv(P, lds, bx, G, tid, wave, lane);
#endif
        float lam, negMb;
        { const float a = P.lq1[lane] * P.lk1[lane] + P.lq1[lane + 64] * P.lk1[lane + 64], c = P.lq2[lane] * P.lk2[lane] + P.lq2[lane + 64] * P.lk2[lane + 64];
          lam = expf(wave_sum(a)) - expf(wave_sum(c)) + LAMBDA_INIT;
          const float gq = wave_max(fmaxf(fabsf(P.q_norm_g[lane]), fabsf(P.q_norm_g[lane + 64]))), gk = wave_max(fmaxf(fabsf(P.k_norm_g[lane]), fabsf(P.k_norm_g[lane + 64])));
          negMb = -(gq * gk * 11.313708498984761f * 1.4426950408889634f * 1.01f);
          lam = __builtin_bit_cast(float, __builtin_amdgcn_readfirstlane(__builtin_bit_cast(int, lam))); negMb = __builtin_bit_cast(float, __builtin_amdgcn_readfirstlane(__builtin_bit_cast(int, negMb))); }
#ifndef NO_ATT
        if (tid < 64) *(LAS f32x4*)(lds + MISC_OFF + 3072 + tid * 16) = *(const f32x4*)(P.subln_g + tid * 4);
        __syncthreads();
        for (int item = vcu; item < 512; item += G) {
            const int bh = item >> 5, pair = item & 31;
            for (int half = 0; half < 2 * REP3; ++half)
                att::attn_block(lds, P, bh >> 2, bh & 3, (half & 1) ? pair : 63 - pair, negMb, lam, tid, wave, lane);
        }
#endif
    }
    SEAM(3);
    if (IN(4)) { MAKE_P(); pg8::Gemm g{P.MIX, P.Wt_out, M_TOK, DM, DM}; pg8::StaticOrder S; S.init(M_TOK, DM, G, bx); pg8::EpiRes E{P.x, P.out, DM};
        pg8::gemm_phase<pg8::EpiRes, pg8::StaticOrder, true, true>(lds, g, S, E); }
    SEAM(4);
    if (IN(5)) { MAKE_P(); f32x4 gg[8]; rms_load_gain(P.norm2_g, gg, lane); for (int m = gw; m < M_TOK; m += NGW) rms_row_to_bf16(P.out + (size_t)m * DM, gg, P.XN + (size_t)m * DM, lane); }
    SEAM(5);
    if (IN(6)) { MAKE_P(); pg8::Gemm g{P.XN, P.Wt_gu, M_TOK, 2 * FFN, DM}; pg8::StaticOrder S; S.init(M_TOK, 2 * FFN, G, bx); S.rep = REP6; pg8::EpiSwiGLU E{P.ACT, FFN};
        pg8::gemm_phase<pg8::EpiSwiGLU, pg8::StaticOrder, true, true>(lds, g, S, E); }
    SEAM(6);
    if (IN(7)) { MAKE_P(); pg8::Gemm g{P.ACT, P.Wt_dn, M_TOK, DM, FFN}; pg8::StaticOrder S; S.init(M_TOK, DM, G, bx); pg8::EpiRes E{P.out, P.out, DM};
        pg8::gemm_phase<pg8::EpiRes, pg8::StaticOrder, true, true>(lds, g, S, E); }
#undef IN
#undef SEAM
}

#ifndef MK_MULTI
#define MK_MULTI 0
#endif
extern "C" void kernel_launch(void* const* d_in, const int* in_sizes, int n_in, void* d_out, int out_size, void* d_ws, size_t ws_size, hipStream_t stream) {
    static int grid = 0;
    if (grid == 0) {
        if (n_in != 19 || ws_size < WS_END) { fprintf(stderr, "kernel_launch: unexpected n_in %d / ws %zu\n", n_in, ws_size); grid = -1; return; }
        int dev = 0, cus = 0, per_cu = 0;
        hipGetDevice(&dev); hipDeviceGetAttribute(&cus, hipDeviceAttributeMultiprocessorCount, dev);
        if (hipFuncSetAttribute((const void*)mega_fwd, hipFuncAttributeMaxDynamicSharedMemorySize, LDS_BYTES) != hipSuccess) { fprintf(stderr, "kernel_launch: hipFuncSetAttribute failed\n"); }
        if (hipOccupancyMaxActiveBlocksPerMultiprocessor(&per_cu, (const void*)mega_fwd, NTHREADS, LDS_BYTES) != hipSuccess || per_cu < 1) { fprintf(stderr, "kernel_launch: occupancy query says %d\n", per_cu); per_cu = 1; }
        (void)hipGetLastError();
        grid = cus * per_cu;
        fprintf(stderr, "kernel_launch: grid %d (cus %d x %d)\n", grid, cus, per_cu);
    }
    if (grid < 0) return;
    if (hipMemsetAsync((char*)d_ws + WS_BAR, 0, BAR_ZERO_BYTES, stream) != hipSuccess) { fprintf(stderr, "kernel_launch: hipMemsetAsync failed\n"); return; }
    Args a{};
    for (int i = 0; i < 19; ++i) a.in[i] = (const float*)d_in[i];
    a.out = (float*)d_out; a.ws = (unsigned char*)d_ws;
#if MK_MULTI
    for (int ph = 0; ph < N_PHASES; ++ph) { a.ph_lo = ph; a.ph_hi = ph + 1; hipLaunchKernelGGL(mega_fwd, dim3(grid), dim3(NTHREADS), LDS_BYTES, stream, a); }
#else
    a.ph_lo = 0; a.ph_hi = N_PHASES;
    void* kargs[] = {(void*)&a};
    hipError_t e = hipLaunchCooperativeKernel((const void*)mega_fwd, dim3(grid), dim3(NTHREADS), kargs, LDS_BYTES, stream);
    if (e != hipSuccess) fprintf(stderr, "kernel_launch: cooperative launch failed: %s (grid %d)\n", hipGetErrorString(e), grid);
#endif
}
```

```cpp
#include <hip/hip_runtime.h>
#include <hip/hip_cooperative_groups.h>
#include <cstdio>
#include <cstdint>
namespace pg8 {
#define PG8_LAS __attribute__((address_space(3)))
typedef unsigned short bf16_t;
typedef short bf16x8 __attribute__((ext_vector_type(8)));
typedef float f32x4 __attribute__((ext_vector_type(4)));
typedef unsigned u32x4 __attribute__((ext_vector_type(4)));
constexpr int BM = 256, BK = 64, HALF = 128, HTB = HALF * BK * 2  , STAGE_BYTES = 8 * HTB, NXCD = 8, WGM = 8;

__host__ __device__ __forceinline__ int lds_byte(int r, int c) { const int st = (r >> 4) * 2 + (c >> 5), rr = r & 15, cc = c & 31, ob = rr * 64 + cc * 2; return st * 1024 + (ob ^ (((ob >> 9) & 1) << 5)); }
__host__ __device__ __forceinline__ void stage_rc(int b, int& R, int& C) { const int st = b / 1024, sb = b % 1024, swz = sb ^ (((sb >> 9) & 1) << 5); R = (st >> 1) * 16 + swz / 64; C = (st & 1) * 32 + (swz % 64) / 2; }
__host__ __device__ __forceinline__ int perm32(int rho) { const int n = rho >> 4, i = rho & 15; return 8 * (i >> 2) + 4 * n + (i & 3); }

struct Unit { int pm, pn; };
struct Gemm { const bf16_t* A; const bf16_t* Bt; int M, N, K; };

struct StaticOrder {
    int nM, nN, nwg, G, c, rep;
    __host__ __device__ void init(int M, int N, int G_, int c_) { nM = M / BM; nN = N / BM; nwg = nM * nN; G = G_; c = c_; rep = 1; }
    __host__ __device__ bool next(int i, Unit& u) const {
        if (rep > 1) { const int cnt = (nwg - c + G - 1) / G; if (i >= cnt * rep) return false; i = i % cnt; }
        const long L = (long)i * G + c; if (L >= nwg) return false;
        int wgid = (int)L; { const int q = nwg / NXCD, r = nwg % NXCD, xcd = wgid % NXCD, off = wgid / NXCD; wgid = (xcd < r ? xcd * (q + 1) : r * (q + 1) + (xcd - r) * q) + off; }
        const int nig = WGM * nN, gid = wgid / nig, fm = gid * WGM, gsz = (nM - fm) < WGM ? (nM - fm) : WGM;
        u.pm = fm + ((wgid % nig) % gsz); u.pn = (wgid % nig) / gsz; return true;
    }
    __device__ __forceinline__ void a_ready(const Unit&) const {}
    __device__ __forceinline__ void done(const Unit&) const {}
};

__device__ __forceinline__ unsigned cvt_pk_bf16(float lo, float hi) { unsigned r; asm volatile("v_cvt_pk_bf16_f32 %0, %1, %2" : "=v"(r) : "v"(lo), "v"(hi)); return r; }
typedef float f32x2 __attribute__((ext_vector_type(2)));
__device__ __forceinline__ float sigmoid_fast(float x) { return __builtin_amdgcn_rcpf(1.0f + __builtin_amdgcn_exp2f(-1.4426950408889634f * x)); }
__device__ __forceinline__ u32x4 pack8(const f32x4 v0, const f32x4 v1) { u32x4 w; w.x = cvt_pk_bf16(v0[0], v0[1]); w.y = cvt_pk_bf16(v0[2], v0[3]); w.z = cvt_pk_bf16(v1[0], v1[1]); w.w = cvt_pk_bf16(v1[2], v1[3]); return w; }

struct EpiProj {
    static constexpr bool PERM = true, AFTER_DRAIN = false;
    bf16_t *Q, *K, *U;
    __device__ __forceinline__ void operator()(const f32x4 (&acc)[2][2][4][2], const Unit& u, int wr, int wc, int fr, int fq) const {
        const int row0 = u.pm * BM + wr * 64 + fr;
        if (u.pn < 8) {
            bf16_t* base = (u.pn < 4 ? Q : K) + (u.pn & 3) * 256 + wc * 32 + 8 * fq;
#pragma unroll
            for (int ai = 0; ai < 2; ++ai)
#pragma unroll
                for (int m = 0; m < 4; ++m) { bf16_t* rowp = base + (size_t)(row0 + ai * HALF + m * 16) * 1024;
#pragma unroll
                    for (int bj = 0; bj < 2; ++bj) *(u32x4*)(rowp + bj * HALF) = pack8(acc[ai][bj][m][0], acc[ai][bj][m][1]); }
        } else {
            bf16_t* base = U + (u.pn - 8) * 128 + wc * 32 + 8 * fq;
#pragma unroll
            for (int ai = 0; ai < 2; ++ai)
#pragma unroll
                for (int m = 0; m < 4; ++m) { bf16_t* rowp = base + (size_t)(row0 + ai * HALF + m * 16) * 1024;
                    f32x4 v[2];
#pragma unroll
                    for (int n = 0; n < 2; ++n) { const f32x4 a = acc[ai][0][m][n], g = acc[ai][1][m][n];
                        v[n] = (f32x4){a[0] * sigmoid_fast(g[0]), a[1] * sigmoid_fast(g[1]), a[2] * sigmoid_fast(g[2]), a[3] * sigmoid_fast(g[3])}; }
                    *(u32x4*)rowp = pack8(v[0], v[1]); }
        }
    }
};
struct EpiPlain {
    static constexpr bool PERM = true, AFTER_DRAIN = false;
    bf16_t* O; int ldc;
    __device__ __forceinline__ void operator()(const f32x4 (&acc)[2][2][4][2], const Unit& u, int wr, int wc, int fr, int fq) const {
        const int row0 = u.pm * BM + wr * 64 + fr; bf16_t* base = O + u.pn * BM + wc * 32 + 8 * fq;
#pragma unroll
        for (int ai = 0; ai < 2; ++ai)
#pragma unroll
            for (int m = 0; m < 4; ++m) { bf16_t* rowp = base + (size_t)(row0 + ai * HALF + m * 16) * ldc;
#pragma unroll
                for (int bj = 0; bj < 2; ++bj) *(u32x4*)(rowp + bj * HALF) = pack8(acc[ai][bj][m][0], acc[ai][bj][m][1]); }
    }
};
struct EpiSwiGLU {
    static constexpr bool PERM = true, AFTER_DRAIN = false;
    bf16_t* O; int ldc;
    __device__ __forceinline__ void operator()(const f32x4 (&acc)[2][2][4][2], const Unit& u, int wr, int wc, int fr, int fq) const {
        const int row0 = u.pm * BM + wr * 64 + fr; bf16_t* base = O + u.pn * 128 + wc * 32 + 8 * fq;
#pragma unroll
        for (int ai = 0; ai < 2; ++ai)
#pragma unroll
            for (int m = 0; m < 4; ++m) { bf16_t* rowp = base + (size_t)(row0 + ai * HALF + m * 16) * ldc;
                f32x4 v[2];
#pragma unroll
                for (int n = 0; n < 2; ++n) { const f32x4 a = acc[ai][0][m][n], b = acc[ai][1][m][n];
                    v[n] = (f32x4){a[0] * sigmoid_fast(a[0]) * b[0], a[1] * sigmoid_fast(a[1]) * b[1], a[2] * sigmoid_fast(a[2]) * b[2], a[3] * sigmoid_fast(a[3]) * b[3]}; }
                *(u32x4*)rowp = pack8(v[0], v[1]); }
    }
};
struct EpiSwiGLUN {
    static constexpr bool PERM = true, AFTER_DRAIN = false;
    bf16_t* O; int ldc; const float* rss;
    __device__ __forceinline__ void operator()(const f32x4 (&acc)[2][2][4][2], const Unit& u, int wr, int wc, int fr, int fq) const {
        const int row0 = u.pm * BM + wr * 64 + fr; bf16_t* base = O + u.pn * 128 + wc * 32 + 8 * fq;
#pragma unroll
        for (int ai = 0; ai < 2; ++ai)
#pragma unroll
            for (int m = 0; m < 4; ++m) { const int row = row0 + ai * HALF + m * 16; bf16_t* rowp = base + (size_t)row * ldc;
                const f32x4 p0 = *(const f32x4*)(rss + (size_t)row * 8), p1 = *(const f32x4*)(rss + (size_t)row * 8 + 4);
                const float rs = 1.0f / sqrtf((((p0[0] + p0[1]) + (p0[2] + p0[3])) + ((p1[0] + p1[1]) + (p1[2] + p1[3]))) * (1.0f / 2048.0f) + 1e-6f);
                f32x4 v[2];
#pragma unroll
                for (int n = 0; n < 2; ++n) { const f32x4 a = acc[ai][0][m][n] * rs, b = acc[ai][1][m][n] * rs;
                    v[n] = (f32x4){a[0] * sigmoid_fast(a[0]) * b[0], a[1] * sigmoid_fast(a[1]) * b[1], a[2] * sigmoid_fast(a[2]) * b[2], a[3] * sigmoid_fast(a[3]) * b[3]}; }
                *(u32x4*)rowp = pack8(v[0], v[1]); }
    }
};
struct EpiSwiGLUR {
    static constexpr bool PERM = true, AFTER_DRAIN = false;
    bf16_t* O; int ldc; const float* rsv;
    __device__ __forceinline__ void operator()(const f32x4 (&acc)[2][2][4][2], const Unit& u, int wr, int wc, int fr, int fq) const {
        const int row0 = u.pm * BM + wr * 64 + fr; bf16_t* base = O + u.pn * 128 + wc * 32 + 8 * fq;
        float rs8[8];
#pragma unroll
        for (int i = 0; i < 8; ++i) rs8[i] = rsv[row0 + (i >> 2) * HALF + (i & 3) * 16];
#pragma unroll
        for (int ai = 0; ai < 2; ++ai)
#pragma unroll
            for (int m = 0; m < 4; ++m) { const int row = row0 + ai * HALF + m * 16; bf16_t* rowp = base + (size_t)row * ldc; const float rs = rs8[ai * 4 + m];
                f32x4 v[2];
#pragma unroll
                for (int n = 0; n < 2; ++n) { const f32x4 a = acc[ai][0][m][n] * rs, b = acc[ai][1][m][n] * rs;
                    v[n] = (f32x4){a[0] * sigmoid_fast(a[0]) * b[0], a[1] * sigmoid_fast(a[1]) * b[1], a[2] * sigmoid_fast(a[2]) * b[2], a[3] * sigmoid_fast(a[3]) * b[3]}; }
                *(u32x4*)rowp = pack8(v[0], v[1]); }
    }
};
struct EpiResNorm {
    static constexpr bool PERM = false, AFTER_DRAIN = false;
    const float* base; float* out; bf16_t* hb; float* rss; int ldc; PG8_LAS float* red;
    __device__ __forceinline__ void operator()(const f32x4 (&acc)[2][2][4][2], const Unit& u, int wr, int wc, int fr, int fq) const {
        const int row0 = u.pm * BM + wr * 64 + fr, col0 = u.pn * BM + wc * 32 + 4 * fq;
#pragma unroll
        for (int ai = 0; ai < 2; ++ai)
#pragma unroll
            for (int m = 0; m < 4; ++m) { const int row = row0 + ai * HALF + m * 16; const size_t off = (size_t)row * ldc + col0; float ss = 0.f;
#pragma unroll
                for (int bj = 0; bj < 2; ++bj)
#pragma unroll
                    for (int n = 0; n < 2; ++n) { const f32x4 h = *(const f32x4*)(base + off + bj * HALF + n * 16) + acc[ai][bj][m][n];
                        *(f32x4*)(out + off + bj * HALF + n * 16) = h; ss += (h[0] * h[0] + h[1] * h[1]) + (h[2] * h[2] + h[3] * h[3]);
                        unsigned long long w = (unsigned long long)cvt_pk_bf16(h[0], h[1]) | ((unsigned long long)cvt_pk_bf16(h[2], h[3]) << 32);
                        *(unsigned long long*)(hb + off + bj * HALF + n * 16) = w; }
                ss += __shfl_xor(ss, 16); ss += __shfl_xor(ss, 32);
                if (fq == 0) red[(ai * HALF + wr * 64 + m * 16 + fr) * 4 + wc] = ss; }
        asm volatile("s_waitcnt lgkmcnt(0)" ::: "memory"); __builtin_amdgcn_s_barrier(); asm volatile("" ::: "memory");
        { const int t = threadIdx.x; if (t < 256) { const f32x4 p = *(const PG8_LAS f32x4*)(red + t * 4); rss[(size_t)(u.pm * BM + t) * 8 + u.pn] = (p[0] + p[1]) + (p[2] + p[3]); } }
        asm volatile("s_waitcnt lgkmcnt(0)" ::: "memory"); __builtin_amdgcn_s_barrier(); asm volatile("" ::: "memory");
    }
};
struct OrderRs : StaticOrder {
    const float* rsv; int wr_, lane_;
    mutable float a0, a1, b0, b1; mutable int n_ready;
    __device__ __forceinline__ void a_ready(const Unit& u) const {
        const float* p = rsv + u.pm * BM + wr_ * 64 + lane_;
        if (n_ready & 1) { b0 = p[0]; b1 = p[HALF]; } else { a0 = p[0]; a1 = p[HALF]; }
        ++n_ready;
    }
};
struct EpiSwiGLUP {
    static constexpr bool PERM = true, AFTER_DRAIN = false;
    bf16_t* O; int ldc; const OrderRs* S; mutable int n_done;
    __device__ __forceinline__ void operator()(const f32x4 (&acc)[2][2][4][2], const Unit& u, int wr, int wc, int fr, int fq) const {
        const int row0 = u.pm * BM + wr * 64 + fr; bf16_t* base = O + u.pn * 128 + wc * 32 + 8 * fq;
        const bool par = (n_done & 1) != 0; ++n_done;
        const float r0 = par ? S->b0 : S->a0, r1 = par ? S->b1 : S->a1;
#pragma unroll
        for (int ai = 0; ai < 2; ++ai)
#pragma unroll
            for (int m = 0; m < 4; ++m) { const int row = row0 + ai * HALF + m * 16; bf16_t* rowp = base + (size_t)row * ldc;
                const float rs = __builtin_bit_cast(float, __builtin_amdgcn_ds_bpermute((m * 16 + fr) << 2, __builtin_bit_cast(int, ai ? r1 : r0)));
                f32x4 v[2];
#pragma unroll
                for (int n = 0; n < 2; ++n) { const f32x4 a = acc[ai][0][m][n] * rs, b = acc[ai][1][m][n] * rs;
                    v[n] = (f32x4){a[0] * sigmoid_fast(a[0]) * b[0], a[1] * sigmoid_fast(a[1]) * b[1], a[2] * sigmoid_fast(a[2]) * b[2], a[3] * sigmoid_fast(a[3]) * b[3]}; }
                *(u32x4*)rowp = pack8(v[0], v[1]); }
    }
};
struct EpiResNorm2 {
    static constexpr bool PERM = true, AFTER_DRAIN = false;
    const float* base; float* out; bf16_t* hb; float* rss; int ldc; PG8_LAS float* red;
    __device__ __forceinline__ void operator()(const f32x4 (&acc)[2][2][4][2], const Unit& u, int wr, int wc, int fr, int fq) const {
        const int row0 = u.pm * BM + wr * 64 + fr, col0 = u.pn * BM + wc * 32 + 8 * fq;
#pragma unroll
        for (int ai = 0; ai < 2; ++ai)
#pragma unroll
            for (int m = 0; m < 4; ++m) { const int row = row0 + ai * HALF + m * 16; const size_t off = (size_t)row * ldc + col0; float ss = 0.f;
#pragma unroll
                for (int bj = 0; bj < 2; ++bj) { const f32x4 h0 = *(const f32x4*)(base + off + bj * HALF) + acc[ai][bj][m][0], h1 = *(const f32x4*)(base + off + bj * HALF + 4) + acc[ai][bj][m][1];
                    *(f32x4*)(out + off + bj * HALF) = h0; *(f32x4*)(out + off + bj * HALF + 4) = h1;
                    ss += ((h0[0] * h0[0] + h0[1] * h0[1]) + (h0[2] * h0[2] + h0[3] * h0[3])) + ((h1[0] * h1[0] + h1[1] * h1[1]) + (h1[2] * h1[2] + h1[3] * h1[3]));
                    *(u32x4*)(hb + off + bj * HALF) = pack8(h0, h1); }
                ss += __shfl_xor(ss, 16); ss += __shfl_xor(ss, 32);
                if (fq == 0) red[(ai * HALF + wr * 64 + m * 16 + fr) * 4 + wc] = ss; }
        asm volatile("s_waitcnt lgkmcnt(0)" ::: "memory"); __builtin_amdgcn_s_barrier(); asm volatile("" ::: "memory");
        { const int t = threadIdx.x; if (t < 256) { const f32x4 p = *(const PG8_LAS f32x4*)(red + t * 4); rss[(size_t)(u.pm * BM + t) * 8 + u.pn] = (p[0] + p[1]) + (p[2] + p[3]); } }
        asm volatile("s_waitcnt lgkmcnt(0)" ::: "memory"); __builtin_amdgcn_s_barrier(); asm volatile("" ::: "memory");
    }
};
struct EpiRes {
    static constexpr bool PERM = false, AFTER_DRAIN = false;
    const float* base; float* out; int ldc;
    __device__ __forceinline__ void operator()(const f32x4 (&acc)[2][2][4][2], const Unit& u, int wr, int wc, int fr, int fq) const {
        const int row0 = u.pm * BM + wr * 64 + fr, col0 = u.pn * BM + wc * 32 + 4 * fq;
#pragma unroll
        for (int ai = 0; ai < 2; ++ai)
#pragma unroll
            for (int m = 0; m < 4; ++m) { const size_t off = (size_t)(row0 + ai * HALF + m * 16) * ldc + col0;
#pragma unroll
                for (int bj = 0; bj < 2; ++bj)
#pragma unroll
                    for (int n = 0; n < 2; ++n) { const f32x4 b = *(const f32x4*)(base + off + bj * HALF + n * 16); *(f32x4*)(out + off + bj * HALF + n * 16) = b + acc[ai][bj][m][n]; } }
    }
};
template <class Epi, class Sched, bool ALIGN_EPI = false, bool SP2 = false>
__device__ __forceinline__ void gemm_phase(PG8_LAS unsigned char* lds, const Gemm g, const Sched& S, const Epi& E) {
    const int tid = threadIdx.x, wid = __builtin_amdgcn_readfirstlane(tid >> 6), lane = tid & 63, wr = wid >> 2, wc = wid & 3, fr = lane & 15, fq = lane >> 4;
    const int K = g.K, nt = K / BK;
    unsigned voffA[2], voffB[2];
#pragma unroll
    for (int i = 0; i < 2; ++i) { int R, C; stage_rc(tid * 16 + i * 8192, R, C); const int Rb = Epi::PERM ? ((R & ~31) + perm32(R & 31)) : R;
        voffA[i] = (unsigned)(R * K + C) * 2u; voffB[i] = (unsigned)(Rb * K + C) * 2u; }
    const size_t kstep = (size_t)(BK * 2);
    const size_t hstep = (size_t)HALF * K * 2;
    const size_t tstep = 2 * hstep;
    const unsigned ldsw = (unsigned)wid * 1024u;
    const int aoff = lds_byte(wr * 64 + fr, fq * 8), boff = lds_byte(wc * 32 + fr, fq * 8);
#define PG8_SA(b, h) (((b) * 2 + (h)) * HTB)
#define PG8_SB(b, h) ((4 + (b) * 2 + (h)) * HTB)
#define PG8_STAGE(bufoff, gbase, voff) do { _Pragma("unroll") for (int _i = 0; _i < 2; ++_i) \
        __builtin_amdgcn_global_load_lds((const unsigned*)((const char*)(gbase) + (voff)[_i]), (PG8_LAS unsigned*)(lds + (bufoff) + ldsw + _i * 8192), 16, 0, 0); } while (0)
#define PG8_LDA(dst, b, h) do { _Pragma("unroll") for (int m = 0; m < 4; ++m) _Pragma("unroll") for (int k = 0; k < 2; ++k) dst[m][k] = *(const PG8_LAS bf16x8*)(lds + PG8_SA(b, h) + aoff + m * 2048 + k * 1024); } while (0)
#define PG8_LDB(dst, b, h) do { _Pragma("unroll") for (int n = 0; n < 2; ++n) _Pragma("unroll") for (int k = 0; k < 2; ++k) dst[n][k] = *(const PG8_LAS bf16x8*)(lds + PG8_SB(b, h) + boff + n * 2048 + k * 1024); } while (0)
#define PG8_MMA(ai, bj, At, Bt) do { __builtin_amdgcn_s_setprio(1); _Pragma("unroll") for (int m = 0; m < 4; ++m) _Pragma("unroll") for (int n = 0; n < 2; ++n) _Pragma("unroll") for (int k = 0; k < 2; ++k) \
        acc[ai][bj][m][n] = __builtin_amdgcn_mfma_f32_16x16x32_bf16(Bt[n][k], At[m][k], acc[ai][bj][m][n], 0, 0, 0); __builtin_amdgcn_s_setprio(0); } while (0)
#define PG8_WAIT_V(n) asm volatile("s_waitcnt vmcnt(" #n ")" ::: "memory")
#define PG8_WAIT_L(n) asm volatile("s_waitcnt lgkmcnt(" #n ")" ::: "memory")
#define PG8_BAR __builtin_amdgcn_s_barrier()
#define PG8_SCHED __builtin_amdgcn_sched_barrier(0)
    Unit cur, nxt; int ui = 0;
    if (!S.next(0, cur)) return;
    f32x4 acc[2][2][4][2];
#pragma unroll
    for (int a = 0; a < 2; ++a)
#pragma unroll
        for (int b = 0; b < 2; ++b)
#pragma unroll
            for (int m = 0; m < 4; ++m)
#pragma unroll
                for (int n = 0; n < 2; ++n) acc[a][b][m][n] = (f32x4){0.f, 0.f, 0.f, 0.f};
    bf16x8 At[4][2], B0[2][2], B1[2][2];
    const char* cA = (const char*)g.A + (size_t)cur.pm * tstep; const char* cB = (const char*)g.Bt + (size_t)cur.pn * tstep;
    S.a_ready(cur);
    if constexpr (SP2) {
        PG8_STAGE(PG8_SB(0, 0), cB, voffB); PG8_STAGE(PG8_SB(0, 1), cB + hstep, voffB); PG8_STAGE(PG8_SA(0, 0), cA, voffA); PG8_STAGE(PG8_SA(0, 1), cA + hstep, voffA);
        if (wr == 1) PG8_BAR;
        PG8_WAIT_V(2); PG8_BAR;
        PG8_STAGE(PG8_SB(1, 0), cB + kstep, voffB); PG8_STAGE(PG8_SA(1, 0), cA + kstep, voffA); PG8_STAGE(PG8_SB(1, 1), cB + hstep + kstep, voffB);
        PG8_WAIT_V(6); PG8_BAR;
    } else {
        PG8_STAGE(PG8_SB(0, 0), cB, voffB); PG8_STAGE(PG8_SA(0, 0), cA, voffA); PG8_STAGE(PG8_SB(0, 1), cB + hstep, voffB); PG8_STAGE(PG8_SA(0, 1), cA + hstep, voffA);
        if (wr == 1) PG8_BAR;
        PG8_WAIT_V(4); PG8_BAR;
        PG8_STAGE(PG8_SB(1, 0), cB + kstep, voffB); PG8_STAGE(PG8_SA(1, 0), cA + kstep, voffA); PG8_STAGE(PG8_SB(1, 1), cB + hstep + kstep, voffB);
        PG8_WAIT_V(6); PG8_BAR;
    }
    for (;;) {
        const bool has_next = S.next(ui + 1, nxt);
        const char* nA = has_next ? (const char*)g.A + (size_t)nxt.pm * tstep : cA; const char* nB = has_next ? (const char*)g.Bt + (size_t)nxt.pn * tstep : cB;
        for (int t = 0; t < nt; t += 2) {
            const bool last = (t == nt - 2);
            const char* a1 = cA + (size_t)(t + 1) * kstep;
            const char* a2 = last ? nA : cA + (size_t)(t + 2) * kstep; const char* b2 = last ? nB : cB + (size_t)(t + 2) * kstep;
            const char* a3 = a2 + kstep; const char* b3 = b2 + kstep;
            if (last && has_next) S.a_ready(nxt);
            if constexpr (SP2) {
            PG8_LDB(B0, 0, 0); PG8_LDB(B1, 0, 1); PG8_SCHED; PG8_LDA(At, 0, 0); PG8_STAGE(PG8_SA(1, 1), a1 + hstep, voffA);
            PG8_WAIT_V(8); PG8_WAIT_L(0); PG8_BAR; PG8_MMA(0, 0, At, B0); PG8_MMA(0, 1, At, B1); PG8_BAR; PG8_SCHED;
            PG8_LDA(At, 0, 1); PG8_STAGE(PG8_SB(0, 0), b2, voffB); PG8_STAGE(PG8_SB(0, 1), b2 + hstep, voffB); PG8_STAGE(PG8_SA(0, 0), a2, voffA);
            PG8_WAIT_V(8); PG8_WAIT_L(0); PG8_BAR; PG8_MMA(1, 0, At, B0); PG8_MMA(1, 1, At, B1); PG8_BAR; PG8_SCHED;
            PG8_LDB(B0, 1, 0); PG8_LDB(B1, 1, 1); PG8_SCHED; PG8_LDA(At, 1, 0); PG8_STAGE(PG8_SA(0, 1), a2 + hstep, voffA);
            PG8_WAIT_V(8); PG8_WAIT_L(0); PG8_BAR; PG8_MMA(0, 0, At, B0); PG8_MMA(0, 1, At, B1); PG8_BAR; PG8_SCHED;
            PG8_LDA(At, 1, 1); PG8_STAGE(PG8_SB(1, 0), b3, voffB); PG8_STAGE(PG8_SB(1, 1), b3 + hstep, voffB); PG8_STAGE(PG8_SA(1, 0), a3, voffA);
            PG8_WAIT_V(8); PG8_WAIT_L(0); PG8_BAR; PG8_MMA(1, 0, At, B0); PG8_MMA(1, 1, At, B1); PG8_BAR; PG8_SCHED;
            } else {
            PG8_LDB(B0, 0, 0); PG8_SCHED; PG8_LDA(At, 0, 0); PG8_STAGE(PG8_SA(1, 1), a1 + hstep, voffA);
            PG8_WAIT_L(8); PG8_BAR; PG8_WAIT_L(0); PG8_MMA(0, 0, At, B0); PG8_BAR; PG8_SCHED;
            PG8_LDB(B1, 0, 1); PG8_STAGE(PG8_SB(0, 0), b2, voffB);
            PG8_BAR; PG8_WAIT_L(0); PG8_MMA(0, 1, At, B1); PG8_BAR;
            PG8_LDA(At, 0, 1); PG8_STAGE(PG8_SA(0, 0), a2, voffA);
            PG8_BAR; PG8_WAIT_L(0); PG8_MMA(1, 0, At, B0); PG8_BAR; PG8_SCHED;
            PG8_STAGE(PG8_SB(0, 1), b2 + hstep, voffB);
            PG8_WAIT_V(6); PG8_BAR; PG8_MMA(1, 1, At, B1); PG8_BAR;
            PG8_LDB(B0, 1, 0); PG8_SCHED; PG8_LDA(At, 1, 0); PG8_STAGE(PG8_SA(0, 1), a2 + hstep, voffA);
            PG8_WAIT_L(8); PG8_BAR; PG8_WAIT_L(0); PG8_MMA(0, 0, At, B0); PG8_BAR; PG8_SCHED;
            PG8_LDB(B1, 1, 1); PG8_STAGE(PG8_SB(1, 0), b3, voffB);
            PG8_BAR; PG8_WAIT_L(0); PG8_MMA(0, 1, At, B1); PG8_BAR;
            PG8_LDA(At, 1, 1); PG8_STAGE(PG8_SA(1, 0), a3, voffA);
            PG8_BAR; PG8_WAIT_L(0); PG8_MMA(1, 0, At, B0); PG8_BAR; PG8_SCHED;
            PG8_STAGE(PG8_SB(1, 1), b3 + hstep, voffB);
            PG8_WAIT_V(6); PG8_BAR; PG8_MMA(1, 1, At, B1); PG8_BAR;
            }
        }
        if constexpr (ALIGN_EPI) { if (wr == 0) PG8_BAR; }
        if constexpr (!Epi::AFTER_DRAIN) { E(acc, cur, wr, wc, fr, fq); S.done(cur); }
        if (!has_next) break;
#pragma unroll
        for (int a = 0; a < 2; ++a)
#pragma unroll
            for (int b = 0; b < 2; ++b)
#pragma unroll
                for (int m = 0; m < 4; ++m)
#pragma unroll
                    for (int n = 0; n < 2; ++n) acc[a][b][m][n] = (f32x4){0.f, 0.f, 0.f, 0.f};
        cur = nxt; cA = nA; cB = nB; ++ui;
        if constexpr (ALIGN_EPI) { if (wr == 1) PG8_BAR; }
    }
    PG8_WAIT_V(0);
    if constexpr (!ALIGN_EPI) { if (wr == 0) PG8_BAR; }
    PG8_BAR;
    if constexpr (Epi::AFTER_DRAIN) { E.fused(acc, cur, wr, wc, fr, fq, lds, wid, lane); S.done(cur); }
#undef PG8_SA
#undef PG8_SB
#undef PG8_STAGE
#undef PG8_LDA
#undef PG8_LDB
#undef PG8_MMA
#undef PG8_WAIT_V
#undef PG8_WAIT_L
#undef PG8_BAR
#undef PG8_SCHED
}
}
constexpr int BATCH = 4, SEQ = 8192, DM = 2048, M_TOK = BATCH * SEQ;
constexpr int NHEAD = 4, HD = 128, VD = 256, ATT_W = 1024, CONV_CH = 1024, CONV_W = 31, IN_COLS = 5120, FFN = 5632;
constexpr float EPS_RMS = 1e-6f, EPS_LN = 1e-5f, LAMBDA_INIT = 0.2f;
constexpr float QSCALE = 0.08838834764831845f * 1.4426950408889634f;
constexpr int NTHREADS = 512, NWAVES = 8;

constexpr size_t MiB = 1u << 20;
constexpr size_t WS_COS = 1 * MiB, WS_SIN = 3 * MiB, WS_RSS = 5 * MiB, WS_RS = 6 * MiB;
constexpr size_t WS_WIN = 8 * MiB;
constexpr size_t WS_WV = 24 * MiB;
constexpr size_t WS_WOUT = 28 * MiB;
constexpr size_t WS_WGU = 36 * MiB;
constexpr size_t WS_WDN = 80 * MiB;
constexpr size_t WS_XN = 104 * MiB;
constexpr size_t WS_Q = 232 * MiB, WS_K = 296 * MiB, WS_VT = 360 * MiB, WS_U = 424 * MiB, WS_MIX = 488 * MiB;
constexpr size_t WS_ACT = 232 * MiB;
constexpr size_t WS_END = 616 * MiB;

#define LAS __attribute__((address_space(3)))
typedef unsigned short bf16;
typedef unsigned v4u __attribute__((ext_vector_type(4)));
typedef unsigned v2u __attribute__((ext_vector_type(2)));
typedef float f32x4 __attribute__((ext_vector_type(4)));
typedef float f32x2 __attribute__((ext_vector_type(2)));
typedef short bf16x8 __attribute__((ext_vector_type(8)));
typedef float f32x16 __attribute__((ext_vector_type(16)));
constexpr int LDS_BYTES = 131072 + 4096 + 64;
constexpr int MISC_OFF = 131072, BARST_OFF = 131072 + 4096;
constexpr size_t WS_BAR = 0, BAR_ZERO_BYTES = 16384;

__device__ __forceinline__ unsigned f2bf(float f) { unsigned u = __builtin_bit_cast(unsigned, f); return (u + 0x7fffu + ((u >> 16) & 1u)) >> 16; }
__device__ __forceinline__ unsigned pk2(float lo, float hi) { return pg8::cvt_pk_bf16(lo, hi); }
__device__ __forceinline__ float bflo(unsigned w) { return __builtin_bit_cast(float, w << 16); }
__device__ __forceinline__ float bfhi(unsigned w) { return __builtin_bit_cast(float, w & 0xffff0000u); }
__device__ __forceinline__ float wave_sum(float v) {
#pragma unroll
    for (int o = 1; o < 64; o <<= 1) v += __shfl_xor(v, o);
    return v;
}
__device__ __forceinline__ float wave_max(float v) {
#pragma unroll
    for (int o = 1; o < 64; o <<= 1) v = fmaxf(v, __shfl_xor(v, o));
    return v;
}
#define LDS_WAIT() asm volatile("s_waitcnt lgkmcnt(0)" ::: "memory")

__device__ __forceinline__ void transpose_item(const float* W, int K, int N, int k0, int n0, bf16* dst, const float* kscale, LAS unsigned char* scr, int lane) {
    const int r = lane >> 4, c = lane & 15;
    f32x4 v[16];
#pragma unroll
    for (int j = 0; j < 8; ++j)
#pragma unroll
        for (int p = 0; p < 2; ++p) v[2 * j + p] = *(const f32x4*)(W + (size_t)(k0 + 8 * j + 2 * r + p) * N + n0 + 4 * c);
#pragma unroll
    for (int j = 0; j < 8; ++j) { const int k = 8 * j + 2 * r; float s0 = 1.0f, s1 = 1.0f; if (kscale) { const f32x2 sc = *(const f32x2*)(kscale + k0 + k); s0 = sc.x; s1 = sc.y; }
#pragma unroll
        for (int i = 0; i < 4; ++i) { const int n = 4 * c + i; *(LAS unsigned*)(scr + n * 128 + ((j ^ (c & 7)) << 4) + 4 * r) = pk2(v[2 * j][i] * s0, v[2 * j + 1][i] * s1); } }
    LDS_WAIT(); asm volatile("" ::: "memory");
    const int rr = lane >> 3, cc = lane & 7;
#pragma unroll
    for (int j = 0; j < 8; ++j) { const int n = 8 * j + rr; const v4u o = *(const LAS v4u*)(scr + n * 128 + ((cc ^ ((n >> 2) & 7)) << 4)); *(v4u*)(dst + (size_t)n * K + k0 + 8 * cc) = o; }
    LDS_WAIT(); asm volatile("" ::: "memory");
}
__device__ __forceinline__ void rms_load_gain(const float* g, f32x4 (&gg)[8], int lane) {
#pragma unroll
    for (int j = 0; j < 8; ++j) gg[j] = *(const f32x4*)(g + 256 * j + 8 * (lane & 31) + 4 * (lane >> 5));
}
__device__ __forceinline__ void rms_row_to_bf16(const float* xrow, const f32x4 (&gg)[8], bf16* orow, int lane) {
    const int lo = lane & 31, hi = lane >> 5;
    const f32x4* xr = (const f32x4*)xrow + 2 * lo + hi;
    f32x4 v[8]; float s = 0.f;
#pragma unroll
    for (int j = 0; j < 8; ++j) { v[j] = xr[64 * j]; s += (v[j].x * v[j].x + v[j].y * v[j].y) + (v[j].z * v[j].z + v[j].w * v[j].w); }
    const float rinv = 1.0f / sqrtf(wave_sum(s) * (1.f / DM) + EPS_RMS);
#pragma unroll
    for (int i = 0; i < 4; ++i) { v2u wa, wb;
        { const f32x4 x = v[2 * i], g = gg[2 * i]; wa.x = pk2(x.x * rinv * g.x, x.y * rinv * g.y); wa.y = pk2(x.z * rinv * g.z, x.w * rinv * g.w); }
        { const f32x4 x = v[2 * i + 1], g = gg[2 * i + 1]; wb.x = pk2(x.x * rinv * g.x, x.y * rinv * g.y); wb.y = pk2(x.z * rinv * g.z, x.w * rinv * g.w); }
        const auto rx = __builtin_amdgcn_permlane32_swap(wa.x, wb.x, false, false);
        const auto ry = __builtin_amdgcn_permlane32_swap(wa.y, wb.y, false, false);
        v4u w16; w16.x = rx[0]; w16.y = ry[0]; w16.z = rx[1]; w16.w = ry[1];
        *(v4u*)(orow + 256 * (2 * i + hi) + 8 * lo) = w16; }
}

struct Ptrs {
    const float *x, *norm1_g, *w_in, *q_norm_g, *k_norm_g, *lq1, *lk1, *lq2, *lk2, *subln_g, *conv_w, *conv_b, *conv_ln_g, *conv_ln_b, *w_out, *norm2_g, *w_gate, *w_up, *w_down;
    float* out;
    bf16 *Wt_in, *Wt_v, *Wt_out, *Wt_gu, *Wt_dn, *XN, *Q, *K, *VT, *U, *MIX, *ACT;
    float *COS, *SIN, *RSS, *RS;
};

__device__ __forceinline__ void p0_prologue(const Ptrs& P, LAS unsigned char* lds, int gw, int NGW, int wave, int lane) {
    LAS unsigned char* scr = lds + wave * 16384;
    constexpr int I_IN = 32 * 80, I_OUT = 32 * 32, I_G = 32 * 88, I_D = 88 * 32;
    constexpr int NITEMS = I_IN + I_OUT + 2 * I_G + I_D;
    for (int it = gw; it < NITEMS; it += NGW) {
        int r = it;
        if (r < I_IN) { const int kb = r / 80, n0 = (r % 80) * 64; bf16* dst;
            if (n0 < 2048) dst = P.Wt_in + (size_t)n0 * DM;
            else if (n0 < 3072) dst = P.Wt_v + (size_t)(n0 - 2048) * DM;
            else if (n0 < 4096) { const int ch = n0 - 3072; dst = P.Wt_in + (size_t)(2048 + (ch >> 7) * 256 + (ch & 127)) * DM; }
            else { const int ch = n0 - 4096; dst = P.Wt_in + (size_t)(2048 + (ch >> 7) * 256 + 128 + (ch & 127)) * DM; }
            transpose_item(P.w_in, DM, IN_COLS, kb * 64, n0, dst, nullptr, scr, lane); continue; }
        r -= I_IN;
        if (r < I_OUT) { const int kb = r / 32, n0 = (r % 32) * 64; transpose_item(P.w_out, DM, DM, kb * 64, n0, P.Wt_out + (size_t)n0 * DM, nullptr, scr, lane); continue; }
        r -= I_OUT;
        if (r < I_G) { const int kb = r / 88, n0 = (r % 88) * 64; transpose_item(P.w_gate, DM, FFN, kb * 64, n0, P.Wt_gu + (size_t)((n0 >> 7) * 256 + (n0 & 127)) * DM, P.norm2_g, scr, lane); continue; }
        r -= I_G;
        if (r < I_G) { const int kb = r / 88, n0 = (r % 88) * 64; transpose_item(P.w_up, DM, FFN, kb * 64, n0, P.Wt_gu + (size_t)((n0 >> 7) * 256 + 128 + (n0 & 127)) * DM, P.norm2_g, scr, lane); continue; }
        r -= I_G;
        { const int kb = r / 32, n0 = (r % 32) * 64; transpose_item(P.w_down, FFN, DM, kb * 64, n0, P.Wt_dn + (size_t)n0 * FFN, nullptr, scr, lane); }
    }
    { f32x4 gg[8]; rms_load_gain(P.norm1_g, gg, lane);
      for (int m = gw; m < M_TOK; m += NGW) rms_row_to_bf16(P.x + (size_t)m * DM, gg, P.XN + (size_t)m * DM, lane); }
    for (int i = gw * 64 + lane; i < SEQ * 64; i += NGW * 64) {
        const int pos = i >> 6, j = i & 63;
        const float inv = (float)exp2(-(double)j * (13.287712379549449 / 64.0));
        const float ang = (float)pos * inv;
        double rev = (double)ang * 0.15915494309189535; rev -= rint(rev);
        const float fr = (float)rev;
        P.COS[i] = __builtin_amdgcn_cosf(fr); P.SIN[i] = __builtin_amdgcn_sinf(fr);
    }
}

__device__ __forceinline__ void p2_qk_norm_rope(const Ptrs& P, int gw, int NGW, int lane) {
    const int sub = lane & 7, grp = lane >> 3;
    f32x4 gq[4], gk[4];
#pragma unroll
    for (int i = 0; i < 4; ++i) { const int o = sub * 8 + (i & 1) * 4 + (i >> 1) * 64; gq[i] = *(const f32x4*)(P.q_norm_g + o); gk[i] = *(const f32x4*)(P.k_norm_g + o); }
    for (int row = gw; row < M_TOK; row += NGW) {
        bf16* pq = P.Q + (size_t)row * 1024 + grp * 128 + sub * 8; bf16* pk = P.K + (size_t)row * 1024 + grp * 128 + sub * 8;
        const v4u q1 = *(const v4u*)pq, q2 = *(const v4u*)(pq + 64), k1 = *(const v4u*)pk, k2 = *(const v4u*)(pk + 64);
        const int pos = row & (SEQ - 1);
        const f32x4 c0 = *(const f32x4*)(P.COS + pos * 64 + sub * 8), c1 = *(const f32x4*)(P.COS + pos * 64 + sub * 8 + 4);
        const f32x4 s0 = *(const f32x4*)(P.SIN + pos * 64 + sub * 8), s1 = *(const f32x4*)(P.SIN + pos * 64 + sub * 8 + 4);
#pragma unroll
        for (int which = 0; which < 2; ++which) {
            const v4u r1 = which ? k1 : q1, r2 = which ? k2 : q2;
            float t1[8], t2[8];
#pragma unroll
            for (int j = 0; j < 4; ++j) { t1[2 * j] = bflo(r1[j]); t1[2 * j + 1] = bfhi(r1[j]); t2[2 * j] = bflo(r2[j]); t2[2 * j + 1] = bfhi(r2[j]); }
            float ss = 0.f;
#pragma unroll
            for (int j = 0; j < 8; ++j) ss += t1[j] * t1[j] + t2[j] * t2[j];
            ss += __shfl_xor(ss, 1); ss += __shfl_xor(ss, 2); ss += __shfl_xor(ss, 4);
            const float rinv = (1.0f / sqrtf(ss * (1.f / HD) + EPS_RMS)) * (which ? 1.0f : QSCALE);
            float o1[8], o2[8];
#pragma unroll
            for (int j = 0; j < 8; ++j) {
                const float cc = j < 4 ? c0[j & 3] : c1[j & 3], sn = j < 4 ? s0[j & 3] : s1[j & 3];
                const float ga = which ? (j < 4 ? gk[0][j & 3] : gk[1][j & 3]) : (j < 4 ? gq[0][j & 3] : gq[1][j & 3]);
                const float gb = which ? (j < 4 ? gk[2][j & 3] : gk[3][j & 3]) : (j < 4 ? gq[2][j & 3] : gq[3][j & 3]);
                const float n1 = t1[j] * rinv * ga, n2 = t2[j] * rinv * gb;
                o1[j] = n1 * cc - n2 * sn; o2[j] = n2 * cc + n1 * sn;
            }
            v4u w1, w2;
#pragma unroll
            for (int j = 0; j < 4; ++j) { w1[j] = pk2(o1[2 * j], o1[2 * j + 1]); w2[j] = pk2(o2[2 * j], o2[2 * j + 1]); }
            bf16* p = which ? pk : pq;
            *(v4u*)p = w1; *(v4u*)(p + 64) = w2;
        }
    }
}

__device__ __forceinline__ void glds16c(const void* sbase, unsigned voff, unsigned lds_dst) {
    unsigned keep;
    asm volatile("s_mov_b32 %0, m0\n\ts_mov_b32 m0, %3\n\ts_nop 0\n\tglobal_load_lds_dwordx4 %1, %2\n\ts_mov_b32 m0, %0" : "=&s"(keep) : "v"(voff), "s"(sbase), "s"(lds_dst) : "memory");
}
#define CBAR() do { LDS_WAIT(); asm volatile("" ::: "memory"); __builtin_amdgcn_s_barrier(); asm volatile("" ::: "memory"); } while (0)
#define CONV_ISSUE(item_) do { const int row0_ = (item_) * 16, s0_ = row0_ & (SEQ - 1); \
        _Pragma("nounroll") for (int k_ = 0; k_ < 12; ++k_) { const int p_ = wave + 8 * k_; if (p_ < 92) { const int r_ = p_ >> 1; const int rr_ = (s0_ - 30 + r_ < 0) ? 30 : r_; \
            glds16c((const char*)P.U + ((size_t)(row0_ - 30 + rr_) * 2048 + (size_t)(p_ & 1) * 1024), (unsigned)lane * 16u, lds0 + (unsigned)p_ * 1024u); } } } while (0)
__device__ __forceinline__ void p3_conv(const Ptrs& P, LAS unsigned char* lds, int first, int stride, int tid, int wave, int lane) {
    const int ch = 2 * tid;
    constexpr int NITEMS = M_TOK / 16, OT_OFF = 94208;
    f32x2 w[CONV_W];
#pragma unroll
    for (int k = 0; k < CONV_W; ++k) w[k] = *(const f32x2*)(P.conv_w + k * CONV_CH + ch);
    const f32x2 cb = *(const f32x2*)(P.conv_b + ch), lg = *(const f32x2*)(P.conv_ln_g + ch), lb = *(const f32x2*)(P.conv_ln_b + ch);
    LAS float* red = (LAS float*)(lds + MISC_OFF);
    LAS float* stat = red + 256;
    int bpi[6];
#pragma unroll
    for (int k = 0; k < 6; ++k) bpi[k] = (lane ^ (1 << k)) << 2;
    const unsigned lds0 = (unsigned)__builtin_amdgcn_readfirstlane((int)(unsigned)(uintptr_t)lds);
    asm volatile("s_waitcnt vmcnt(0)" ::: "memory");
#pragma unroll
    for (int k = 0; k < CONV_W; ++k) asm volatile("" : "+v"(w[k]));
    if (first < NITEMS) CONV_ISSUE(first);
    for (int item = first; item < NITEMS; item += stride) {
        const int row0 = item * 16, s0 = row0 & (SEQ - 1);
        asm volatile("s_waitcnt vmcnt(0)" ::: "memory");
        CBAR();
        unsigned uv[46];
#pragma unroll
        for (int r = 0; r < 46; ++r) { const int neg = (s0 - 30 + r) >> 31;
            uv[r] = *(const LAS unsigned*)(lds + r * 2048 + tid * 4) & ~(unsigned)neg; }
        CBAR();
        if (item + stride < NITEMS) CONV_ISSUE(item + stride);
        f32x2 a[16];
#pragma unroll
        for (int t = 0; t < 16; ++t) a[t] = cb;
#pragma unroll
        for (int r = 0; r < 46; ++r) {
            const f32x2 u = (f32x2){bflo(uv[r]), bfhi(uv[r])};
#pragma unroll
            for (int t = 0; t < 16; ++t) { const int k = r - t; if (k >= 0 && k < CONV_W) a[t] += u * w[k]; }
        }
#pragma unroll
        for (int t = 0; t < 16; ++t) {
            float s1 = a[t].x + a[t].y, s2 = a[t].x * a[t].x + a[t].y * a[t].y;
#pragma unroll
            for (int k = 0; k < 6; ++k) {
                s1 += __builtin_bit_cast(float, __builtin_amdgcn_ds_bpermute(bpi[k], __builtin_bit_cast(int, s1)));
                s2 += __builtin_bit_cast(float, __builtin_amdgcn_ds_bpermute(bpi[k], __builtin_bit_cast(int, s2)));
            }
            if (lane == 0) { red[(wave * 16 + t) * 2] = s1; red[(wave * 16 + t) * 2 + 1] = s2; }
        }
        CBAR();
        if (tid < 16) { float s1 = 0.f, s2 = 0.f;
#pragma unroll
            for (int ww = 0; ww < 8; ++ww) { s1 += red[(ww * 16 + tid) * 2]; s2 += red[(ww * 16 + tid) * 2 + 1]; }
            const float mu = s1 * (1.f / CONV_CH), var = fmaxf(s2 * (1.f / CONV_CH) - mu * mu, 0.f);
            stat[tid * 2] = mu; stat[tid * 2 + 1] = 1.0f / sqrtf(var + EPS_LN); }
        CBAR();
#pragma unroll
        for (int t = 0; t < 16; ++t) {
            const float mu = stat[t * 2], rs = stat[t * 2 + 1];
            const float y0 = (a[t].x - mu) * rs * lg.x + lb.x, y1 = (a[t].y - mu) * rs * lg.y + lb.y;
            *(LAS unsigned*)(lds + OT_OFF + t * 2048 + tid * 4) = pk2(y0 * pg8::sigmoid_fast(y0), y1 * pg8::sigmoid_fast(y1));
        }
        CBAR();
#pragma unroll
        for (int k = 0; k < 4; ++k) { const int c = tid + 512 * k; const v4u v = *(const LAS v4u*)(lds + OT_OFF + c * 16);
            *(v4u*)((char*)P.MIX + ((size_t)(row0 + (c >> 7)) * DM + ATT_W) * 2 + (size_t)(c & 127) * 16) = v; }
        CBAR();
    }
    asm volatile("s_waitcnt vmcnt(0)" ::: "memory");
}
#undef CONV_ISSUE
#undef CBAR

namespace att {
constexpr int BUF = 65536, V_OFF = 32768;
__device__ __forceinline__ void glds16(const void* sbase, unsigned voff, unsigned lds_dst) {
    unsigned keep;
    asm volatile("s_mov_b32 %0, m0\n\ts_mov_b32 m0, %3\n\ts_nop 0\n\tglobal_load_lds_dwordx4 %1, %2\n\ts_mov_b32 m0, %0" : "=&s"(keep) : "v"(voff), "s"(sbase), "s"(lds_dst) : "memory");
}
__device__ __forceinline__ int pi32(int i) { return (i & ~12) | ((i & 4) << 1) | ((i & 8) >> 1); }
#define ATT_WAIT_V(n) asm volatile("s_waitcnt vmcnt(" #n ")" ::: "memory")
#define ATT_BAR() do { asm volatile("" ::: "memory"); __builtin_amdgcn_s_barrier(); asm volatile("" ::: "memory"); } while (0)

__device__ __forceinline__ void attn_block(LAS unsigned char* lds, const Ptrs& P, int b, int h, int qb, float negMb, float lam, int tid, int wid, int lane) {
    const int comp = wid & 1, quarter = wid >> 1, l31 = lane & 31, hh = lane >> 5;
    const int NT = 2 * qb + 2;
    const size_t tok0 = (size_t)b * SEQ;
    const int qpos = qb * 128 + quarter * 32 + l31;
    bf16x8 qf[8];
    { const bf16* qp = P.Q + (tok0 + qpos) * 1024 + h * 256 + comp * 128 + hh * 8;
#pragma unroll
      for (int ks = 0; ks < 8; ++ks) qf[ks] = *(const bf16x8*)(qp + ks * 16); }
    const unsigned ldsw = (unsigned)wid * 4096u;
    const unsigned lds0 = (unsigned)__builtin_amdgcn_readfirstlane((int)(unsigned)(uintptr_t)lds);
    unsigned kb0, kx16, vb0, vy16;
    { int ln_ = lane; asm volatile("" : "+v"(ln_));
      kb0 = (unsigned)(((16 * (wid & 3) + (ln_ >> 4)) * 1024 + h * 256 + (wid >> 2) * 128) * 2); kx16 = (unsigned)(((ln_ & 15) ^ (ln_ >> 4)) << 4);
      vb0 = (unsigned)(((h * 256 + 32 * wid + (ln_ >> 3)) * M_TOK) * 2); vy16 = (unsigned)(((ln_ & 7) ^ (ln_ >> 4)) << 4);
      asm volatile("" : "+v"(kb0), "+v"(kx16), "+v"(vb0), "+v"(vy16)); }
#define ATT_DMA(t, bufi) do { const char* kb_ = (const char*)P.K + (tok0 + (size_t)(t) * 64) * 2048; const char* vb_ = (const char*)P.VT + (tok0 + (size_t)(t) * 64) * 2; \
        _Pragma("unroll") for (int pp = 0; pp < 4; ++pp) glds16(kb_, kb0 + pp * 8192 + (kx16 ^ (64 * pp)), lds0 + (bufi) * BUF + ldsw + pp * 1024); \
        _Pragma("unroll") for (int pp = 0; pp < 4; ++pp) glds16(vb_, vb0 + pp * (8 * M_TOK * 2) + (vy16 ^ (64 * (pp & 1))), lds0 + (bufi) * BUF + V_OFF + ldsw + pp * 1024); } while (0)
    f32x16 o[8];
#pragma unroll
    for (int e = 0; e < 8; ++e)
#pragma unroll
        for (int r = 0; r < 16; ++r) o[e][r] = 0.f;
    float lsum = 0.f;
    ATT_WAIT_V(0);
#pragma unroll
    for (int ks = 0; ks < 8; ++ks) asm volatile("" : "+v"(qf[ks]));
    ATT_DMA(0, 0);
    const bool early = wid < 4;
    for (int t = 0; t < NT; ++t) {
        ATT_WAIT_V(0);
        LDS_WAIT();
        ATT_BAR();
        const bool more = t + 1 < NT;
        if (more && early) ATT_DMA(t + 1, (t + 1) & 1);
        const bool active = (quarter >= 2) || more;
        const LAS unsigned char* base = lds + (t & 1) * BUF;
        int ln2 = lane; asm volatile("" : "+v"(ln2));
        const int l31b = ln2 & 31, hhb = ln2 >> 5;
        const int krow = pi32(l31b), kx = krow & 15;
        const int koffr = comp * 16384 + krow * 256;
        const int vx = (l31b >> 1) & 7;
        const int voffr = V_OFF + l31b * 128;
#pragma unroll
        for (int T = 0; T < 2; ++T) {
            if (T == 1 && more && !early) ATT_DMA(t + 1, (t + 1) & 1);
            if (active) {
                f32x16 s;
#pragma unroll
                for (int r = 0; r < 16; ++r) s[r] = negMb;
#pragma unroll
                for (int ks = 0; ks < 8; ++ks) {
                    const bf16x8 kf = *(const LAS bf16x8*)(base + koffr + T * 8192 + (((2 * ks + hhb) ^ kx) << 4));
                    s = __builtin_amdgcn_mfma_f32_32x32x16_bf16(kf, qf[ks], s, 0, 0, 0);
                }
                float ps = 0.f;
#pragma unroll
                for (int r = 0; r < 16; ++r) { s[r] = __builtin_amdgcn_exp2f(s[r]); ps += s[r]; }
                lsum += ps;
#pragma unroll
                for (int sI = 0; sI < 2; ++sI) { v4u w;
#pragma unroll
                    for (int j = 0; j < 4; ++j) w[j] = pk2(s[8 * sI + 2 * j], s[8 * sI + 2 * j + 1]);
                    const bf16x8 pf = __builtin_bit_cast(bf16x8, w);
                    const LAS unsigned char* vb = base + voffr + (((2 * (2 * T + sI) + hhb) ^ vx) << 4);
#pragma unroll
                    for (int e = 0; e < 8; ++e) {
                        const bf16x8 vf = *(const LAS bf16x8*)(vb + e * 4096);
                        o[e] = __builtin_amdgcn_mfma_f32_32x32x16_bf16(vf, pf, o[e], 0, 0, 0);
                    }
                }
            }
        }
    }
    LDS_WAIT();
    ATT_BAR();
    const float ltot = lsum + __shfl_xor(lsum, 32);
    const float inv = 1.0f / ltot;
    int ln3 = lane; asm volatile("" : "+v"(ln3));
    const int hh3 = ln3 >> 5, qpos3 = qb * 128 + quarter * 32 + (ln3 & 31);
    LAS unsigned char* xb = lds + quarter * 32768 + ln3 * 16;
    if (comp == 1) {
        const float sc = lam * inv;
#pragma unroll
        for (int e = 0; e < 8; ++e)
#pragma unroll
            for (int r4 = 0; r4 < 4; ++r4) *(LAS f32x4*)(xb + (e * 4 + r4) * 1024) = (f32x4){o[e][4 * r4] * sc, o[e][4 * r4 + 1] * sc, o[e][4 * r4 + 2] * sc, o[e][4 * r4 + 3] * sc};
    }
    LDS_WAIT();
    ATT_BAR();
    if (comp == 0) {
        float ss = 0.f;
#pragma unroll
        for (int e = 0; e < 8; ++e)
#pragma unroll
            for (int r4 = 0; r4 < 4; ++r4) { const f32x4 x1 = *(const LAS f32x4*)(xb + (e * 4 + r4) * 1024);
#pragma unroll
                for (int i = 0; i < 4; ++i) { const float v = o[e][4 * r4 + i] * inv - x1[i]; o[e][4 * r4 + i] = v; ss += v * v; } }
        ss += __shfl_xor(ss, 32);
        const float rn = (1.0f / sqrtf(ss * (1.f / VD) + EPS_RMS)) * (1.0f - LAMBDA_INIT);
        bf16* orow = P.MIX + (tok0 + qpos3) * DM + h * 256 + 8 * hh3;
        const LAS float* gp = (const LAS float*)(lds + MISC_OFF + 3072) + 4 * hh3;
#pragma unroll
        for (int e = 0; e < 8; ++e)
#pragma unroll
            for (int i2 = 0; i2 < 2; ++i2) { v2u wab[2];
#pragma unroll
                for (int q = 0; q < 2; ++q) { const int r4 = 2 * i2 + q; const f32x4 g = *(const LAS f32x4*)(gp + 32 * e + 8 * r4);
                    wab[q].x = pk2(o[e][4 * r4] * rn * g[0], o[e][4 * r4 + 1] * rn * g[1]); wab[q].y = pk2(o[e][4 * r4 + 2] * rn * g[2], o[e][4 * r4 + 3] * rn * g[3]); }
                const auto rx = __builtin_amdgcn_permlane32_swap(wab[0].x, wab[1].x, false, false);
                const auto ry = __builtin_amdgcn_permlane32_swap(wab[0].y, wab[1].y, false, false);
                v4u w16; w16.x = rx[0]; w16.y = ry[0]; w16.z = rx[1]; w16.w = ry[1];
                *(v4u*)(orow + 32 * e + 16 * i2) = w16; }
    }
    LDS_WAIT();
    ATT_BAR();
#undef ATT_DMA
}
}

#define XB_TMO      128
#define XB_XCNT(j)  (256  + 64 * (j))
#define XB_XSUB(j)  (1280 + 64 * (j))
#define XB_XGEN(j)  (2304 + 64 * (j))
#define XB_TOP      3328
#define XB_TOPGEN   3392
#define XCD_BAR_WORDS 3456
#define XB_SPIN_CAP (1u << 18)

__device__ __forceinline__ unsigned xb_ld(unsigned* p)              { return __hip_atomic_load(p, __ATOMIC_RELAXED, __HIP_MEMORY_SCOPE_AGENT); }
__device__ __forceinline__ unsigned xb_add(unsigned* p, unsigned v) { return __hip_atomic_fetch_add(p, v, __ATOMIC_RELAXED, __HIP_MEMORY_SCOPE_AGENT); }
__device__ __forceinline__ unsigned xb_xcc_id() { return (unsigned)__builtin_amdgcn_s_getreg((3 << 11) | 20) & 0xFu; }
#define XB_SPIN(cond, bar) do { unsigned _sp = 0; while (cond) { __builtin_amdgcn_s_sleep(1); \
    if ((++_sp & 255u) == 0u) { if (xb_ld(&(bar)[XB_TMO])) break; if (_sp > XB_SPIN_CAP) { atomicAdd(&(bar)[XB_TMO], 1u); break; } } } } while (0)

struct XcdBarrier {
    unsigned* bar; unsigned x;
    volatile LAS unsigned* st;
};

__device__ __forceinline__ XcdBarrier xcd_barrier_post(unsigned* bar, volatile LAS unsigned* st) {
    XcdBarrier b; b.bar = bar; b.x = xb_xcc_id(); b.st = st;
    if (threadIdx.x == 0) (void)xb_add(&bar[XB_XCNT(b.x)], 1u);
    return b;
}
__device__ __forceinline__ void xcd_barrier_complete(unsigned* bar, unsigned x, unsigned& nloc, unsigned& nx) {
    const unsigned G = gridDim.x * gridDim.y * gridDim.z;
    unsigned sum, cnt, mine, sp = 0u;
    for (;;) {
        sum = 0u; cnt = 0u; mine = 0u;
#pragma unroll
        for (unsigned j = 0; j < 16; ++j) { const unsigned c = xb_ld(&bar[XB_XCNT(j)]); sum += c; cnt += (c > 0u) ? 1u : 0u; mine = (j == x) ? c : mine; }
        if (sum == G) break;
        __builtin_amdgcn_s_sleep(1);
        if ((++sp & 255u) == 0u) { if (xb_ld(&bar[XB_TMO])) break; if (sp > XB_SPIN_CAP) { atomicAdd(&bar[XB_TMO], 1u); break; } }
    }
    nloc = mine > 0u ? mine : 1u; nx = cnt > 0u ? cnt : 1u;
}

__device__ __forceinline__ void xcd_barrier(const XcdBarrier& b) {
    asm volatile("s_waitcnt vmcnt(0)" ::: "memory");
    __syncthreads();
    if (threadIdx.x == 0) {
        unsigned* bar = b.bar;
        __builtin_amdgcn_s_waitcnt(0);
        unsigned nloc = b.st[0], nx = b.st[1];
        if (nloc == 0u) { xcd_barrier_complete(bar, b.x, nloc, nx); b.st[0] = nloc; b.st[1] = nx; }
        const unsigned old = xb_add(&bar[XB_XSUB(b.x)], 1u);
        const unsigned gen = old / nloc;
        if (old + 1u == (gen + 1u) * nloc) {
            __builtin_amdgcn_fence(__ATOMIC_RELEASE, "agent");
            asm volatile("s_waitcnt vmcnt(0)" ::: "memory");
            const unsigned og = xb_add(&bar[XB_TOP], 1u);
            const unsigned tg = og / nx;
            if (og + 1u == (tg + 1u) * nx) xb_add(&bar[XB_TOPGEN], 1u);
            else XB_SPIN(xb_ld(&bar[XB_TOPGEN]) == tg, bar);
            __builtin_amdgcn_fence(__ATOMIC_ACQUIRE, "agent");
            xb_add(&bar[XB_XGEN(b.x)], 1u);
            asm volatile("s_waitcnt vmcnt(0)" ::: "memory");
        } else {
            XB_SPIN(xb_ld(&bar[XB_XGEN(b.x)]) == gen, bar);
            __builtin_amdgcn_fence(__ATOMIC_ACQUIRE, "agent");
            asm volatile("s_waitcnt vmcnt(0)" ::: "memory");
        }
    }
    __syncthreads();
}

struct Args { const float* in[19]; float* out; unsigned char* ws; int ph_lo, ph_hi; };
constexpr int N_PHASES = 8;

__global__ void __launch_bounds__(NTHREADS) mega_fwd(Args args) {
    extern __shared__ __attribute__((aligned(16))) unsigned char lds_raw[];
    LAS unsigned char* lds = (LAS unsigned char*)lds_raw;
    const int tid = threadIdx.x, lane = tid & 63, wave = __builtin_amdgcn_readfirstlane(tid >> 6);
    const int G = gridDim.x, bx = blockIdx.x;
    const int vcu = (G % 8 == 0) ? (bx % 8) * (G / 8) + bx / 8 : bx;
    const int gw = vcu * NWAVES + wave, NGW = G * NWAVES;
    unsigned char* ws = args.ws;
#define MAKE_P() Ptrs P; { unsigned char* w_ = args.ws; asm volatile("" : "+s"(w_)); \
    P.x = args.in[0]; P.norm1_g = args.in[1]; P.w_in = args.in[2]; P.q_norm_g = args.in[3]; P.k_norm_g = args.in[4]; P.lq1 = args.in[5]; P.lk1 = args.in[6]; P.lq2 = args.in[7]; P.lk2 = args.in[8]; \
    P.subln_g = args.in[9]; P.conv_w = args.in[10]; P.conv_b = args.in[11]; P.conv_ln_g = args.in[12]; P.conv_ln_b = args.in[13]; P.w_out = args.in[14]; P.norm2_g = args.in[15]; \
    P.w_gate = args.in[16]; P.w_up = args.in[17]; P.w_down = args.in[18]; P.out = args.out; \
    P.Wt_in = (bf16*)(w_ + WS_WIN); P.Wt_v = (bf16*)(w_ + WS_WV); P.Wt_out = (bf16*)(w_ + WS_WOUT); P.Wt_gu = (bf16*)(w_ + WS_WGU); P.Wt_dn = (bf16*)(w_ + WS_WDN); \
    P.XN = (bf16*)(w_ + WS_XN); P.Q = (bf16*)(w_ + WS_Q); P.K = (bf16*)(w_ + WS_K); P.VT = (bf16*)(w_ + WS_VT); P.U = (bf16*)(w_ + WS_U); P.MIX = (bf16*)(w_ + WS_MIX); P.ACT = (bf16*)(w_ + WS_ACT); \
    P.COS = (float*)(w_ + WS_COS); P.SIN = (float*)(w_ + WS_SIN); P.RSS = (float*)(w_ + WS_RSS); P.RS = (float*)(w_ + WS_RS); }
    const int lo = args.ph_lo, hi = args.ph_hi;
    if (tid < 2) ((volatile LAS unsigned*)(lds + BARST_OFF))[tid] = 0u;
    __syncthreads();
    XcdBarrier gbar = xcd_barrier_post((unsigned*)(ws + WS_BAR), (volatile LAS unsigned*)(lds + BARST_OFF));
#ifndef PHASE_MASK
#define PHASE_MASK 0xff
#endif
#define IN(k) (((PHASE_MASK >> (k)) & 1) && lo <= (k) && (k) < hi)
#ifndef REP3
#define REP3 1
#endif
#ifndef REP6
#define REP6 1
#endif
#ifndef REP1
#define REP1 1
#endif
#define SEAM(k) do { if (IN(k) && IN((k) + 1)) { if (args.ph_hi > 1000) cooperative_groups::this_grid().sync(); else xcd_barrier(gbar); } } while (0)

    if (IN(0)) { MAKE_P(); p0_prologue(P, lds, gw, NGW, wave, lane); }
    SEAM(0);
    if (IN(1)) {
        MAKE_P();
        { pg8::Gemm g{P.XN, P.Wt_in, M_TOK, 4096, DM}; pg8::StaticOrder S; S.init(M_TOK, 4096, G, bx); S.rep = REP1; pg8::EpiProj E{P.Q, P.K, P.U};
          pg8::gemm_phase<pg8::EpiProj, pg8::StaticOrder, true, true>(lds, g, S, E); }
        { pg8::Gemm g{P.Wt_v, P.XN, 1024, M_TOK, DM}; pg8::StaticOrder S; S.init(1024, M_TOK, G, bx); pg8::EpiPlain E{P.VT, M_TOK};
          pg8::gemm_phase<pg8::EpiPlain, pg8::StaticOrder, true, true>(lds, g, S, E); }
    }
    SEAM(1);
    if (IN(2)) { MAKE_P(); p2_qk_norm_rope(P, gw, NGW, lane); }
    SEAM(2);
    if (IN(3)) {
        MAKE_P();
#ifndef NO_CONV
        p3_conv(P, lds, bx, G, tid, wave, lane);
#endif
        float lam, negMb;
        { const float a = P.lq1[lane] * P.lk1[lane] + P.lq1[lane + 64] * P.lk1[lane + 64], c = P.lq2[lane] * P.lk2[lane] + P.lq2[lane + 64] * P.lk2[lane + 64];
          lam = expf(wave_sum(a)) - expf(wave_sum(c)) + LAMBDA_INIT;
          const float gq = wave_max(fmaxf(fabsf(P.q_norm_g[lane]), fabsf(P.q_norm_g[lane + 64]))), gk = wave_max(fmaxf(fabsf(P.k_norm_g[lane]), fabsf(P.k_norm_g[lane + 64])));
          negMb = -(gq * gk * 11.313708498984761f * 1.4426950408889634f * 1.01f);
          lam = __builtin_bit_cast(float, __builtin_amdgcn_readfirstlane(__builtin_bit_cast(int, lam))); negMb = __builtin_bit_cast(float, __builtin_amdgcn_readfirstlane(__builtin_bit_cast(int, negMb))); }
#ifndef NO_ATT
        if (tid < 64) *(LAS f32x4*)(lds + MISC_OFF + 3072 + tid * 16) = *(const f32x4*)(P.subln_g + tid * 4);
        __syncthreads();
        for (int item = vcu; item < 512; item += G) {
            const int bh = item >> 5, pair = item & 31;
            for (int half = 0; half < 2 * REP3; ++half)
                att::attn_block(lds, P, bh >> 2, bh & 3, (half & 1) ? pair : 63 - pair, negMb, lam, tid, wave, lane);
        }
#endif
    }
    SEAM(3);
    if (IN(4)) { MAKE_P(); pg8::Gemm g{P.MIX, P.Wt_out, M_TOK, DM, DM}; pg8::StaticOrder S; S.init(M_TOK, DM, G, bx); pg8::EpiResNorm2 E{P.x, P.out, P.XN, P.RSS, DM, (LAS float*)(lds + MISC_OFF)};
        pg8::gemm_phase<pg8::EpiResNorm2, pg8::StaticOrder, true, true>(lds, g, S, E); }
    SEAM(4);
    if (IN(5)) { MAKE_P(); const int i = (vcu * NWAVES + wave) * 64 + lane;
        if (i < M_TOK) { const f32x4 p0 = *(const f32x4*)(P.RSS + (size_t)i * 8), p1 = *(const f32x4*)(P.RSS + (size_t)i * 8 + 4);
            P.RS[i] = 1.0f / sqrtf((((p0[0] + p0[1]) + (p0[2] + p0[3])) + ((p1[0] + p1[1]) + (p1[2] + p1[3]))) * (1.0f / DM) + EPS_RMS); } }
    SEAM(5);
    if (IN(6)) { MAKE_P(); pg8::Gemm g{P.XN, P.Wt_gu, M_TOK, 2 * FFN, DM}; pg8::OrderRs S; S.init(M_TOK, 2 * FFN, G, bx); S.rsv = P.RS; S.wr_ = wave >> 2; S.lane_ = lane; S.a0 = S.a1 = S.b0 = S.b1 = 0.f; S.n_ready = 0; pg8::EpiSwiGLUP E{P.ACT, FFN, &S, 0};
        pg8::gemm_phase<pg8::EpiSwiGLUP, pg8::OrderRs, true, true>(lds, g, S, E); }
    SEAM(6);
    if (IN(7)) { MAKE_P(); pg8::Gemm g{P.ACT, P.Wt_dn, M_TOK, DM, FFN}; pg8::StaticOrder S; S.init(M_TOK, DM, G, bx); pg8::EpiRes E{P.out, P.out, DM};
        pg8::gemm_phase<pg8::EpiRes, pg8::StaticOrder, true, true>(lds, g, S, E); }
#undef IN
#undef SEAM
}

#ifndef MK_MULTI
#define MK_MULTI 0
#endif
extern "C" void kernel_launch(void* const* d_in, const int* in_sizes, int n_in, void* d_out, int out_size, void* d_ws, size_t ws_size, hipStream_t stream) {
    static int grid = 0;
    if (grid == 0) {
        if (n_in != 19 || ws_size < WS_END) { fprintf(stderr, "kernel_launch: unexpected n_in %d / ws %zu\n", n_in, ws_size); grid = -1; return; }
        int dev = 0, cus = 0, per_cu = 0;
        hipGetDevice(&dev); hipDeviceGetAttribute(&cus, hipDeviceAttributeMultiprocessorCount, dev);
        if (hipFuncSetAttribute((const void*)mega_fwd, hipFuncAttributeMaxDynamicSharedMemorySize, LDS_BYTES) != hipSuccess) { fprintf(stderr, "kernel_launch: hipFuncSetAttribute failed\n"); }
        if (hipOccupancyMaxActiveBlocksPerMultiprocessor(&per_cu, (const void*)mega_fwd, NTHREADS, LDS_BYTES) != hipSuccess || per_cu < 1) { fprintf(stderr, "kernel_launch: occupancy query says %d\n", per_cu); per_cu = 1; }
        (void)hipGetLastError();
        grid = cus * per_cu;
        fprintf(stderr, "kernel_launch: grid %d (cus %d x %d)\n", grid, cus, per_cu);
    }
    if (grid < 0) return;
    if (hipMemsetAsync((char*)d_ws + WS_BAR, 0, BAR_ZERO_BYTES, stream) != hipSuccess) { fprintf(stderr, "kernel_launch: hipMemsetAsync failed\n"); return; }
    Args a{};
    for (int i = 0; i < 19; ++i) a.in[i] = (const float*)d_in[i];
    a.out = (float*)d_out; a.ws = (unsigned char*)d_ws;
#if MK_MULTI
    for (int ph = 0; ph < N_PHASES; ++ph) { a.ph_lo = ph; a.ph_hi = ph + 1; hipLaunchKernelGGL(mega_fwd, dim3(grid), dim3(NTHREADS), LDS_BYTES, stream, a); }
#else
    a.ph_lo = 0; a.ph_hi = N_PHASES;
    void* kargs[] = {(void*)&a};
    hipError_t e = hipLaunchCooperativeKernel((const void*)mega_fwd, dim3(grid), dim3(NTHREADS), kargs, LDS_BYTES, stream);
    if (e != hipSuccess) fprintf(stderr, "kernel_launch: cooperative launch failed: %s (grid %d)\n", hipGetErrorString(e), grid);
#endif
}
```

```cpp
#include <hip/hip_runtime.h>
#include <hip/hip_cooperative_groups.h>
#include <cstdio>
#include <cstdint>
namespace pg8 {
#define PG8_LAS __attribute__((address_space(3)))
typedef unsigned short bf16_t;
typedef short bf16x8 __attribute__((ext_vector_type(8)));
typedef float f32x4 __attribute__((ext_vector_type(4)));
typedef unsigned u32x4 __attribute__((ext_vector_type(4)));
constexpr int BM = 256, BK = 64, HALF = 128, HTB = HALF * BK * 2  , STAGE_BYTES = 8 * HTB, NXCD = 8, WGM = 8;

__host__ __device__ __forceinline__ int lds_byte(int r, int c) { const int st = (r >> 4) * 2 + (c >> 5), rr = r & 15, cc = c & 31, ob = rr * 64 + cc * 2; return st * 1024 + (ob ^ (((ob >> 9) & 1) << 5)); }
__host__ __device__ __forceinline__ void stage_rc(int b, int& R, int& C) { const int st = b / 1024, sb = b % 1024, swz = sb ^ (((sb >> 9) & 1) << 5); R = (st >> 1) * 16 + swz / 64; C = (st & 1) * 32 + (swz % 64) / 2; }
__host__ __device__ __forceinline__ int perm32(int rho) { const int n = rho >> 4, i = rho & 15; return 8 * (i >> 2) + 4 * n + (i & 3); }

struct Unit { int pm, pn; };
struct Gemm { const bf16_t* A; const bf16_t* Bt; int M, N, K; };

struct StaticOrder {
    int nM, nN, nwg, G, c, rep;
    __host__ __device__ void init(int M, int N, int G_, int c_) { nM = M / BM; nN = N / BM; nwg = nM * nN; G = G_; c = c_; rep = 1; }
    __host__ __device__ bool next(int i, Unit& u) const {
        if (rep > 1) { const int cnt = (nwg - c + G - 1) / G; if (i >= cnt * rep) return false; i = i % cnt; }
        const long L = (long)i * G + c; if (L >= nwg) return false;
        int wgid = (int)L; { const int q = nwg / NXCD, r = nwg % NXCD, xcd = wgid % NXCD, off = wgid / NXCD; wgid = (xcd < r ? xcd * (q + 1) : r * (q + 1) + (xcd - r) * q) + off; }
        const int nig = WGM * nN, gid = wgid / nig, fm = gid * WGM, gsz = (nM - fm) < WGM ? (nM - fm) : WGM;
        u.pm = fm + ((wgid % nig) % gsz); u.pn = (wgid % nig) / gsz; return true;
    }
    __device__ __forceinline__ void a_ready(const Unit&) const {}
    __device__ __forceinline__ void done(const Unit&) const {}
};

__device__ __forceinline__ unsigned cvt_pk_bf16(float lo, float hi) { unsigned r; asm volatile("v_cvt_pk_bf16_f32 %0, %1, %2" : "=v"(r) : "v"(lo), "v"(hi)); return r; }
typedef float f32x2 __attribute__((ext_vector_type(2)));
__device__ __forceinline__ float sigmoid_fast(float x) { return __builtin_amdgcn_rcpf(1.0f + __builtin_amdgcn_exp2f(-1.4426950408889634f * x)); }
__device__ __forceinline__ u32x4 pack8(const f32x4 v0, const f32x4 v1) { u32x4 w; w.x = cvt_pk_bf16(v0[0], v0[1]); w.y = cvt_pk_bf16(v0[2], v0[3]); w.z = cvt_pk_bf16(v1[0], v1[1]); w.w = cvt_pk_bf16(v1[2], v1[3]); return w; }

struct EpiProj {
    static constexpr bool PERM = true, AFTER_DRAIN = false;
    bf16_t *Q, *K, *U;
    __device__ __forceinline__ void operator()(const f32x4 (&acc)[2][2][4][2], const Unit& u, int wr, int wc, int fr, int fq) const {
        const int row0 = u.pm * BM + wr * 64 + fr;
        if (u.pn < 8) {
            bf16_t* base = (u.pn < 4 ? Q : K) + (u.pn & 3) * 256 + wc * 32 + 8 * fq;
#pragma unroll
            for (int ai = 0; ai < 2; ++ai)
#pragma unroll
                for (int m = 0; m < 4; ++m) { bf16_t* rowp = base + (size_t)(row0 + ai * HALF + m * 16) * 1024;
#pragma unroll
                    for (int bj = 0; bj < 2; ++bj) *(u32x4*)(rowp + bj * HALF) = pack8(acc[ai][bj][m][0], acc[ai][bj][m][1]); }
        } else {
            bf16_t* base = U + (u.pn - 8) * 128 + wc * 32 + 8 * fq;
#pragma unroll
            for (int ai = 0; ai < 2; ++ai)
#pragma unroll
                for (int m = 0; m < 4; ++m) { bf16_t* rowp = base + (size_t)(row0 + ai * HALF + m * 16) * 1024;
                    f32x4 v[2];
#pragma unroll
                    for (int n = 0; n < 2; ++n) { const f32x4 a = acc[ai][0][m][n], g = acc[ai][1][m][n];
                        v[n] = (f32x4){a[0] * sigmoid_fast(g[0]), a[1] * sigmoid_fast(g[1]), a[2] * sigmoid_fast(g[2]), a[3] * sigmoid_fast(g[3])}; }
                    *(u32x4*)rowp = pack8(v[0], v[1]); }
        }
    }
};
struct EpiPlain {
    static constexpr bool PERM = true, AFTER_DRAIN = false;
    bf16_t* O; int ldc;
    __device__ __forceinline__ void operator()(const f32x4 (&acc)[2][2][4][2], const Unit& u, int wr, int wc, int fr, int fq) const {
        const int row0 = u.pm * BM + wr * 64 + fr; bf16_t* base = O + u.pn * BM + wc * 32 + 8 * fq;
#pragma unroll
        for (int ai = 0; ai < 2; ++ai)
#pragma unroll
            for (int m = 0; m < 4; ++m) { bf16_t* rowp = base + (size_t)(row0 + ai * HALF + m * 16) * ldc;
#pragma unroll
                for (int bj = 0; bj < 2; ++bj) *(u32x4*)(rowp + bj * HALF) = pack8(acc[ai][bj][m][0], acc[ai][bj][m][1]); }
    }
};
struct EpiSwiGLU {
    static constexpr bool PERM = true, AFTER_DRAIN = false;
    bf16_t* O; int ldc;
    __device__ __forceinline__ void operator()(const f32x4 (&acc)[2][2][4][2], const Unit& u, int wr, int wc, int fr, int fq) const {
        const int row0 = u.pm * BM + wr * 64 + fr; bf16_t* base = O + u.pn * 128 + wc * 32 + 8 * fq;
#pragma unroll
        for (int ai = 0; ai < 2; ++ai)
#pragma unroll
            for (int m = 0; m < 4; ++m) { bf16_t* rowp = base + (size_t)(row0 + ai * HALF + m * 16) * ldc;
                f32x4 v[2];
#pragma unroll
                for (int n = 0; n < 2; ++n) { const f32x4 a = acc[ai][0][m][n], b = acc[ai][1][m][n];
                    v[n] = (f32x4){a[0] * sigmoid_fast(a[0]) * b[0], a[1] * sigmoid_fast(a[1]) * b[1], a[2] * sigmoid_fast(a[2]) * b[2], a[3] * sigmoid_fast(a[3]) * b[3]}; }
                *(u32x4*)rowp = pack8(v[0], v[1]); }
    }
};
struct EpiSwiGLUN {
    static constexpr bool PERM = true, AFTER_DRAIN = false;
    bf16_t* O; int ldc; const float* rss;
    __device__ __forceinline__ void operator()(const f32x4 (&acc)[2][2][4][2], const Unit& u, int wr, int wc, int fr, int fq) const {
        const int row0 = u.pm * BM + wr * 64 + fr; bf16_t* base = O + u.pn * 128 + wc * 32 + 8 * fq;
#pragma unroll
        for (int ai = 0; ai < 2; ++ai)
#pragma unroll
            for (int m = 0; m < 4; ++m) { const int row = row0 + ai * HALF + m * 16; bf16_t* rowp = base + (size_t)row * ldc;
                const f32x4 p0 = *(const f32x4*)(rss + (size_t)row * 8), p1 = *(const f32x4*)(rss + (size_t)row * 8 + 4);
                const float rs = 1.0f / sqrtf((((p0[0] + p0[1]) + (p0[2] + p0[3])) + ((p1[0] + p1[1]) + (p1[2] + p1[3]))) * (1.0f / 2048.0f) + 1e-6f);
                f32x4 v[2];
#pragma unroll
                for (int n = 0; n < 2; ++n) { const f32x4 a = acc[ai][0][m][n] * rs, b = acc[ai][1][m][n] * rs;
                    v[n] = (f32x4){a[0] * sigmoid_fast(a[0]) * b[0], a[1] * sigmoid_fast(a[1]) * b[1], a[2] * sigmoid_fast(a[2]) * b[2], a[3] * sigmoid_fast(a[3]) * b[3]}; }
                *(u32x4*)rowp = pack8(v[0], v[1]); }
    }
};
struct EpiSwiGLUR {
    static constexpr bool PERM = true, AFTER_DRAIN = false;
    bf16_t* O; int ldc; const float* rsv;
    __device__ __forceinline__ void operator()(const f32x4 (&acc)[2][2][4][2], const Unit& u, int wr, int wc, int fr, int fq) const {
        const int row0 = u.pm * BM + wr * 64 + fr; bf16_t* base = O + u.pn * 128 + wc * 32 + 8 * fq;
        float rs8[8];
#pragma unroll
        for (int i = 0; i < 8; ++i) rs8[i] = rsv[row0 + (i >> 2) * HALF + (i & 3) * 16];
#pragma unroll
        for (int ai = 0; ai < 2; ++ai)
#pragma unroll
            for (int m = 0; m < 4; ++m) { const int row = row0 + ai * HALF + m * 16; bf16_t* rowp = base + (size_t)row * ldc; const float rs = rs8[ai * 4 + m];
                f32x4 v[2];
#pragma unroll
                for (int n = 0; n < 2; ++n) { const f32x4 a = acc[ai][0][m][n] * rs, b = acc[ai][1][m][n] * rs;
                    v[n] = (f32x4){a[0] * sigmoid_fast(a[0]) * b[0], a[1] * sigmoid_fast(a[1]) * b[1], a[2] * sigmoid_fast(a[2]) * b[2], a[3] * sigmoid_fast(a[3]) * b[3]}; }
                *(u32x4*)rowp = pack8(v[0], v[1]); }
    }
};
struct EpiResNorm {
    static constexpr bool PERM = false, AFTER_DRAIN = false;
    const float* base; float* out; bf16_t* hb; float* rss; int ldc; PG8_LAS float* red;
    __device__ __forceinline__ void operator()(const f32x4 (&acc)[2][2][4][2], const Unit& u, int wr, int wc, int fr, int fq) const {
        const int row0 = u.pm * BM + wr * 64 + fr, col0 = u.pn * BM + wc * 32 + 4 * fq;
#pragma unroll
        for (int ai = 0; ai < 2; ++ai)
#pragma unroll
            for (int m = 0; m < 4; ++m) { const int row = row0 + ai * HALF + m * 16; const size_t off = (size_t)row * ldc + col0; float ss = 0.f;
#pragma unroll
                for (int bj = 0; bj < 2; ++bj)
#pragma unroll
                    for (int n = 0; n < 2; ++n) { const f32x4 h = *(const f32x4*)(base + off + bj * HALF + n * 16) + acc[ai][bj][m][n];
                        *(f32x4*)(out + off + bj * HALF + n * 16) = h; ss += (h[0] * h[0] + h[1] * h[1]) + (h[2] * h[2] + h[3] * h[3]);
                        unsigned long long w = (unsigned long long)cvt_pk_bf16(h[0], h[1]) | ((unsigned long long)cvt_pk_bf16(h[2], h[3]) << 32);
                        *(unsigned long long*)(hb + off + bj * HALF + n * 16) = w; }
                ss += __shfl_xor(ss, 16); ss += __shfl_xor(ss, 32);
                if (fq == 0) red[(ai * HALF + wr * 64 + m * 16 + fr) * 4 + wc] = ss; }
        asm volatile("s_waitcnt lgkmcnt(0)" ::: "memory"); __builtin_amdgcn_s_barrier(); asm volatile("" ::: "memory");
        { const int t = threadIdx.x; if (t < 256) { const f32x4 p = *(const PG8_LAS f32x4*)(red + t * 4); rss[(size_t)(u.pm * BM + t) * 8 + u.pn] = (p[0] + p[1]) + (p[2] + p[3]); } }
        asm volatile("s_waitcnt lgkmcnt(0)" ::: "memory"); __builtin_amdgcn_s_barrier(); asm volatile("" ::: "memory");
    }
};
struct OrderRs : StaticOrder {
    const float* rsv; int wr_, lane_;
    mutable float a0, a1, b0, b1; mutable int n_ready;
    __device__ __forceinline__ void a_ready(const Unit& u) const {
        const float* p = rsv + u.pm * BM + wr_ * 64 + lane_;
        if (n_ready & 1) { b0 = p[0]; b1 = p[HALF]; } else { a0 = p[0]; a1 = p[HALF]; }
        ++n_ready;
    }
};
struct EpiSwiGLUP {
    static constexpr bool PERM = true, AFTER_DRAIN = false;
    bf16_t* O; int ldc; const OrderRs* S; mutable int n_done;
    __device__ __forceinline__ void operator()(const f32x4 (&acc)[2][2][4][2], const Unit& u, int wr, int wc, int fr, int fq) const {
        const int row0 = u.pm * BM + wr * 64 + fr; bf16_t* base = O + u.pn * 128 + wc * 32 + 8 * fq;
        const bool par = (n_done & 1) != 0; ++n_done;
        const float r0 = par ? S->b0 : S->a0, r1 = par ? S->b1 : S->a1;
#pragma unroll
        for (int ai = 0; ai < 2; ++ai)
#pragma unroll
            for (int m = 0; m < 4; ++m) { const int row = row0 + ai * HALF + m * 16; bf16_t* rowp = base + (size_t)row * ldc;
                const float rs = __builtin_bit_cast(float, __builtin_amdgcn_ds_bpermute((m * 16 + fr) << 2, __builtin_bit_cast(int, ai ? r1 : r0)));
                f32x4 v[2];
#pragma unroll
                for (int n = 0; n < 2; ++n) { const f32x4 a = acc[ai][0][m][n] * rs, b = acc[ai][1][m][n] * rs;
                    v[n] = (f32x4){a[0] * sigmoid_fast(a[0]) * b[0], a[1] * sigmoid_fast(a[1]) * b[1], a[2] * sigmoid_fast(a[2]) * b[2], a[3] * sigmoid_fast(a[3]) * b[3]}; }
                *(u32x4*)rowp = pack8(v[0], v[1]); }
    }
};
struct EpiResNorm2 {
    static constexpr bool PERM = true, AFTER_DRAIN = false;
    const float* base; float* out; bf16_t* hb; float* rss; int ldc; PG8_LAS float* red;
    __device__ __forceinline__ void operator()(const f32x4 (&acc)[2][2][4][2], const Unit& u, int wr, int wc, int fr, int fq) const {
        const int row0 = u.pm * BM + wr * 64 + fr, col0 = u.pn * BM + wc * 32 + 8 * fq;
#pragma unroll
        for (int ai = 0; ai < 2; ++ai)
#pragma unroll
            for (int m = 0; m < 4; ++m) { const int row = row0 + ai * HALF + m * 16; const size_t off = (size_t)row * ldc + col0; float ss = 0.f;
#pragma unroll
                for (int bj = 0; bj < 2; ++bj) { const f32x4 h0 = *(const f32x4*)(base + off + bj * HALF) + acc[ai][bj][m][0], h1 = *(const f32x4*)(base + off + bj * HALF + 4) + acc[ai][bj][m][1];
                    ss += ((h0[0] * h0[0] + h0[1] * h0[1]) + (h0[2] * h0[2] + h0[3] * h0[3])) + ((h1[0] * h1[0] + h1[1] * h1[1]) + (h1[2] * h1[2] + h1[3] * h1[3]));
                    *(u32x4*)(hb + off + bj * HALF) = pack8(h0, h1); }
                ss += __shfl_xor(ss, 16); ss += __shfl_xor(ss, 32);
                if (fq == 0) red[(ai * HALF + wr * 64 + m * 16 + fr) * 4 + wc] = ss; }
        asm volatile("s_waitcnt lgkmcnt(0)" ::: "memory"); __builtin_amdgcn_s_barrier(); asm volatile("" ::: "memory");
        { const int t = threadIdx.x; if (t < 256) { const f32x4 p = *(const PG8_LAS f32x4*)(red + t * 4); rss[(size_t)(u.pm * BM + t) * 8 + u.pn] = (p[0] + p[1]) + (p[2] + p[3]); } }
        asm volatile("s_waitcnt lgkmcnt(0)" ::: "memory"); __builtin_amdgcn_s_barrier(); asm volatile("" ::: "memory");
    }
};
struct EpiResB {
    static constexpr bool PERM = true, AFTER_DRAIN = false;
    const bf16_t* hb; float* out; int ldc;
    __device__ __forceinline__ void operator()(const f32x4 (&acc)[2][2][4][2], const Unit& u, int wr, int wc, int fr, int fq) const {
        const int row0 = u.pm * BM + wr * 64 + fr, col0 = u.pn * BM + wc * 32 + 8 * fq;
#pragma unroll
        for (int ai = 0; ai < 2; ++ai)
#pragma unroll
            for (int m = 0; m < 4; ++m) { const size_t off = (size_t)(row0 + ai * HALF + m * 16) * ldc + col0;
#pragma unroll
                for (int bj = 0; bj < 2; ++bj) { const u32x4 w = *(const u32x4*)(hb + off + bj * HALF);
                    const f32x4 h0 = {__builtin_bit_cast(float, w.x << 16), __builtin_bit_cast(float, w.x & 0xffff0000u), __builtin_bit_cast(float, w.y << 16), __builtin_bit_cast(float, w.y & 0xffff0000u)};
                    const f32x4 h1 = {__builtin_bit_cast(float, w.z << 16), __builtin_bit_cast(float, w.z & 0xffff0000u), __builtin_bit_cast(float, w.w << 16), __builtin_bit_cast(float, w.w & 0xffff0000u)};
                    *(f32x4*)(out + off + bj * HALF) = h0 + acc[ai][bj][m][0]; *(f32x4*)(out + off + bj * HALF + 4) = h1 + acc[ai][bj][m][1]; } }
    }
};
struct EpiRes {
    static constexpr bool PERM = false, AFTER_DRAIN = false;
    const float* base; float* out; int ldc;
    __device__ __forceinline__ void operator()(const f32x4 (&acc)[2][2][4][2], const Unit& u, int wr, int wc, int fr, int fq) const {
        const int row0 = u.pm * BM + wr * 64 + fr, col0 = u.pn * BM + wc * 32 + 4 * fq;
#pragma unroll
        for (int ai = 0; ai < 2; ++ai)
#pragma unroll
            for (int m = 0; m < 4; ++m) { const size_t off = (size_t)(row0 + ai * HALF + m * 16) * ldc + col0;
#pragma unroll
                for (int bj = 0; bj < 2; ++bj)
#pragma unroll
                    for (int n = 0; n < 2; ++n) { const f32x4 b = *(const f32x4*)(base + off + bj * HALF + n * 16); *(f32x4*)(out + off + bj * HALF + n * 16) = b + acc[ai][bj][m][n]; } }
    }
};
template <class Epi, class Sched, bool ALIGN_EPI = false, bool SP2 = false>
__device__ __forceinline__ void gemm_phase(PG8_LAS unsigned char* lds, const Gemm g, const Sched& S, const Epi& E) {
    const int tid = threadIdx.x, wid = __builtin_amdgcn_readfirstlane(tid >> 6), lane = tid & 63, wr = wid >> 2, wc = wid & 3, fr = lane & 15, fq = lane >> 4;
    const int K = g.K, nt = K / BK;
    unsigned voffA[2], voffB[2];
#pragma unroll
    for (int i = 0; i < 2; ++i) { int R, C; stage_rc(tid * 16 + i * 8192, R, C); const int Rb = Epi::PERM ? ((R & ~31) + perm32(R & 31)) : R;
        voffA[i] = (unsigned)(R * K + C) * 2u; voffB[i] = (unsigned)(Rb * K + C) * 2u; }
    const size_t kstep = (size_t)(BK * 2);
    const size_t hstep = (size_t)HALF * K * 2;
    const size_t tstep = 2 * hstep;
    const unsigned ldsw = (unsigned)wid * 1024u;
    const int aoff = lds_byte(wr * 64 + fr, fq * 8), boff = lds_byte(wc * 32 + fr, fq * 8);
#define PG8_SA(b, h) (((b) * 2 + (h)) * HTB)
#define PG8_SB(b, h) ((4 + (b) * 2 + (h)) * HTB)
#define PG8_STAGE(bufoff, gbase, voff) do { _Pragma("unroll") for (int _i = 0; _i < 2; ++_i) \
        __builtin_amdgcn_global_load_lds((const unsigned*)((const char*)(gbase) + (voff)[_i]), (PG8_LAS unsigned*)(lds + (bufoff) + ldsw + _i * 8192), 16, 0, 0); } while (0)
#define PG8_LDA(dst, b, h) do { _Pragma("unroll") for (int m = 0; m < 4; ++m) _Pragma("unroll") for (int k = 0; k < 2; ++k) dst[m][k] = *(const PG8_LAS bf16x8*)(lds + PG8_SA(b, h) + aoff + m * 2048 + k * 1024); } while (0)
#define PG8_LDB(dst, b, h) do { _Pragma("unroll") for (int n = 0; n < 2; ++n) _Pragma("unroll") for (int k = 0; k < 2; ++k) dst[n][k] = *(const PG8_LAS bf16x8*)(lds + PG8_SB(b, h) + boff + n * 2048 + k * 1024); } while (0)
#define PG8_MMA(ai, bj, At, Bt) do { __builtin_amdgcn_s_setprio(1); _Pragma("unroll") for (int m = 0; m < 4; ++m) _Pragma("unroll") for (int n = 0; n < 2; ++n) _Pragma("unroll") for (int k = 0; k < 2; ++k) \
        acc[ai][bj][m][n] = __builtin_amdgcn_mfma_f32_16x16x32_bf16(Bt[n][k], At[m][k], acc[ai][bj][m][n], 0, 0, 0); __builtin_amdgcn_s_setprio(0); } while (0)
#define PG8_WAIT_V(n) asm volatile("s_waitcnt vmcnt(" #n ")" ::: "memory")
#define PG8_WAIT_L(n) asm volatile("s_waitcnt lgkmcnt(" #n ")" ::: "memory")
#define PG8_BAR __builtin_amdgcn_s_barrier()
#define PG8_SCHED __builtin_amdgcn_sched_barrier(0)
    Unit cur, nxt; int ui = 0;
    if (!S.next(0, cur)) return;
    f32x4 acc[2][2][4][2];
#pragma unroll
    for (int a = 0; a < 2; ++a)
#pragma unroll
        for (int b = 0; b < 2; ++b)
#pragma unroll
            for (int m = 0; m < 4; ++m)
#pragma unroll
                for (int n = 0; n < 2; ++n) acc[a][b][m][n] = (f32x4){0.f, 0.f, 0.f, 0.f};
    bf16x8 At[4][2], B0[2][2], B1[2][2];
    const char* cA = (const char*)g.A + (size_t)cur.pm * tstep; const char* cB = (const char*)g.Bt + (size_t)cur.pn * tstep;
    S.a_ready(cur);
    if constexpr (SP2) {
        PG8_STAGE(PG8_SB(0, 0), cB, voffB); PG8_STAGE(PG8_SB(0, 1), cB + hstep, voffB); PG8_STAGE(PG8_SA(0, 0), cA, voffA); PG8_STAGE(PG8_SA(0, 1), cA + hstep, voffA);
        if (wr == 1) PG8_BAR;
        PG8_WAIT_V(2); PG8_BAR;
        PG8_STAGE(PG8_SB(1, 0), cB + kstep, voffB); PG8_STAGE(PG8_SA(1, 0), cA + kstep, voffA); PG8_STAGE(PG8_SB(1, 1), cB + hstep + kstep, voffB);
        PG8_WAIT_V(6); PG8_BAR;
    } else {
        PG8_STAGE(PG8_SB(0, 0), cB, voffB); PG8_STAGE(PG8_SA(0, 0), cA, voffA); PG8_STAGE(PG8_SB(0, 1), cB + hstep, voffB); PG8_STAGE(PG8_SA(0, 1), cA + hstep, voffA);
        if (wr == 1) PG8_BAR;
        PG8_WAIT_V(4); PG8_BAR;
        PG8_STAGE(PG8_SB(1, 0), cB + kstep, voffB); PG8_STAGE(PG8_SA(1, 0), cA + kstep, voffA); PG8_STAGE(PG8_SB(1, 1), cB + hstep + kstep, voffB);
        PG8_WAIT_V(6); PG8_BAR;
    }
    for (;;) {
        const bool has_next = S.next(ui + 1, nxt);
        const char* nA = has_next ? (const char*)g.A + (size_t)nxt.pm * tstep : cA; const char* nB = has_next ? (const char*)g.Bt + (size_t)nxt.pn * tstep : cB;
        for (int t = 0; t < nt; t += 2) {
            const bool last = (t == nt - 2);
            const char* a1 = cA + (size_t)(t + 1) * kstep;
            const char* a2 = last ? nA : cA + (size_t)(t + 2) * kstep; const char* b2 = last ? nB : cB + (size_t)(t + 2) * kstep;
            const char* a3 = a2 + kstep; const char* b3 = b2 + kstep;
            if (last && has_next) S.a_ready(nxt);
            if constexpr (SP2) {
            PG8_LDB(B0, 0, 0); PG8_LDB(B1, 0, 1); PG8_SCHED; PG8_LDA(At, 0, 0); PG8_STAGE(PG8_SA(1, 1), a1 + hstep, voffA);
            PG8_WAIT_V(8); PG8_WAIT_L(0); PG8_BAR; PG8_MMA(0, 0, At, B0); PG8_MMA(0, 1, At, B1); PG8_BAR; PG8_SCHED;
            PG8_LDA(At, 0, 1); PG8_STAGE(PG8_SB(0, 0), b2, voffB); PG8_STAGE(PG8_SB(0, 1), b2 + hstep, voffB); PG8_STAGE(PG8_SA(0, 0), a2, voffA);
            PG8_WAIT_V(8); PG8_WAIT_L(0); PG8_BAR; PG8_MMA(1, 0, At, B0); PG8_MMA(1, 1, At, B1); PG8_BAR; PG8_SCHED;
            PG8_LDB(B0, 1, 0); PG8_LDB(B1, 1, 1); PG8_SCHED; PG8_LDA(At, 1, 0); PG8_STAGE(PG8_SA(0, 1), a2 + hstep, voffA);
            PG8_WAIT_V(8); PG8_WAIT_L(0); PG8_BAR; PG8_MMA(0, 0, At, B0); PG8_MMA(0, 1, At, B1); PG8_BAR; PG8_SCHED;
            PG8_LDA(At, 1, 1); PG8_STAGE(PG8_SB(1, 0), b3, voffB); PG8_STAGE(PG8_SB(1, 1), b3 + hstep, voffB); PG8_STAGE(PG8_SA(1, 0), a3, voffA);
            PG8_WAIT_V(8); PG8_WAIT_L(0); PG8_BAR; PG8_MMA(1, 0, At, B0); PG8_MMA(1, 1, At, B1); PG8_BAR; PG8_SCHED;
            } else {
            PG8_LDB(B0, 0, 0); PG8_SCHED; PG8_LDA(At, 0, 0); PG8_STAGE(PG8_SA(1, 1), a1 + hstep, voffA);
            PG8_WAIT_L(8); PG8_BAR; PG8_WAIT_L(0); PG8_MMA(0, 0, At, B0); PG8_BAR; PG8_SCHED;
            PG8_LDB(B1, 0, 1); PG8_STAGE(PG8_SB(0, 0), b2, voffB);
            PG8_BAR; PG8_WAIT_L(0); PG8_MMA(0, 1, At, B1); PG8_BAR;
            PG8_LDA(At, 0, 1); PG8_STAGE(PG8_SA(0, 0), a2, voffA);
            PG8_BAR; PG8_WAIT_L(0); PG8_MMA(1, 0, At, B0); PG8_BAR; PG8_SCHED;
            PG8_STAGE(PG8_SB(0, 1), b2 + hstep, voffB);
            PG8_WAIT_V(6); PG8_BAR; PG8_MMA(1, 1, At, B1); PG8_BAR;
            PG8_LDB(B0, 1, 0); PG8_SCHED; PG8_LDA(At, 1, 0); PG8_STAGE(PG8_SA(0, 1), a2 + hstep, voffA);
            PG8_WAIT_L(8); PG8_BAR; PG8_WAIT_L(0); PG8_MMA(0, 0, At, B0); PG8_BAR; PG8_SCHED;
            PG8_LDB(B1, 1, 1); PG8_STAGE(PG8_SB(1, 0), b3, voffB);
            PG8_BAR; PG8_WAIT_L(0); PG8_MMA(0, 1, At, B1); PG8_BAR;
            PG8_LDA(At, 1, 1); PG8_STAGE(PG8_SA(1, 0), a3, voffA);
            PG8_BAR; PG8_WAIT_L(0); PG8_MMA(1, 0, At, B0); PG8_BAR; PG8_SCHED;
            PG8_STAGE(PG8_SB(1, 1), b3 + hstep, voffB);
            PG8_WAIT_V(6); PG8_BAR; PG8_MMA(1, 1, At, B1); PG8_BAR;
            }
        }
        if constexpr (ALIGN_EPI) { if (wr == 0) PG8_BAR; }
        if constexpr (!Epi::AFTER_DRAIN) { E(acc, cur, wr, wc, fr, fq); S.done(cur); }
        if (!has_next) break;
#pragma unroll
        for (int a = 0; a < 2; ++a)
#pragma unroll
            for (int b = 0; b < 2; ++b)
#pragma unroll
                for (int m = 0; m < 4; ++m)
#pragma unroll
                    for (int n = 0; n < 2; ++n) acc[a][b][m][n] = (f32x4){0.f, 0.f, 0.f, 0.f};
        cur = nxt; cA = nA; cB = nB; ++ui;
        if constexpr (ALIGN_EPI) { if (wr == 1) PG8_BAR; }
    }
    PG8_WAIT_V(0);
    if constexpr (!ALIGN_EPI) { if (wr == 0) PG8_BAR; }
    PG8_BAR;
    if constexpr (Epi::AFTER_DRAIN) { E.fused(acc, cur, wr, wc, fr, fq, lds, wid, lane); S.done(cur); }
#undef PG8_SA
#undef PG8_SB
#undef PG8_STAGE
#undef PG8_LDA
#undef PG8_LDB
#undef PG8_MMA
#undef PG8_WAIT_V
#undef PG8_WAIT_L
#undef PG8_BAR
#undef PG8_SCHED
}
}
constexpr int BATCH = 4, SEQ = 8192, DM = 2048, M_TOK = BATCH * SEQ;
constexpr int NHEAD = 4, HD = 128, VD = 256, ATT_W = 1024, CONV_CH = 1024, CONV_W = 31, IN_COLS = 5120, FFN = 5632;
constexpr float EPS_RMS = 1e-6f, EPS_LN = 1e-5f, LAMBDA_INIT = 0.2f;
constexpr float QSCALE = 0.08838834764831845f * 1.4426950408889634f;
constexpr int NTHREADS = 512, NWAVES = 8;

constexpr size_t MiB = 1u << 20;
constexpr size_t WS_COS = 1 * MiB, WS_SIN = 3 * MiB, WS_RSS = 5 * MiB, WS_RS = 6 * MiB;
constexpr size_t WS_WIN = 8 * MiB;
constexpr size_t WS_WV = 24 * MiB;
constexpr size_t WS_WOUT = 28 * MiB;
constexpr size_t WS_WGU = 36 * MiB;
constexpr size_t WS_WDN = 80 * MiB;
constexpr size_t WS_XN = 104 * MiB;
constexpr size_t WS_Q = 232 * MiB, WS_K = 296 * MiB, WS_VT = 360 * MiB, WS_U = 424 * MiB, WS_MIX = 488 * MiB;
constexpr size_t WS_ACT = 232 * MiB;
constexpr size_t WS_END = 616 * MiB;

#define LAS __attribute__((address_space(3)))
typedef unsigned short bf16;
typedef unsigned v4u __attribute__((ext_vector_type(4)));
typedef unsigned v2u __attribute__((ext_vector_type(2)));
typedef float f32x4 __attribute__((ext_vector_type(4)));
typedef float f32x2 __attribute__((ext_vector_type(2)));
typedef short bf16x8 __attribute__((ext_vector_type(8)));
typedef float f32x16 __attribute__((ext_vector_type(16)));
constexpr int LDS_BYTES = 131072 + 4096 + 64;
constexpr int MISC_OFF = 131072, BARST_OFF = 131072 + 4096;
constexpr size_t WS_BAR = 0, BAR_ZERO_BYTES = 16384;

__device__ __forceinline__ unsigned f2bf(float f) { unsigned u = __builtin_bit_cast(unsigned, f); return (u + 0x7fffu + ((u >> 16) & 1u)) >> 16; }
__device__ __forceinline__ unsigned pk2(float lo, float hi) { return pg8::cvt_pk_bf16(lo, hi); }
__device__ __forceinline__ float bflo(unsigned w) { return __builtin_bit_cast(float, w << 16); }
__device__ __forceinline__ float bfhi(unsigned w) { return __builtin_bit_cast(float, w & 0xffff0000u); }
__device__ __forceinline__ float wave_sum(float v) {
#pragma unroll
    for (int o = 1; o < 64; o <<= 1) v += __shfl_xor(v, o);
    return v;
}
__device__ __forceinline__ float wave_max(float v) {
#pragma unroll
    for (int o = 1; o < 64; o <<= 1) v = fmaxf(v, __shfl_xor(v, o));
    return v;
}
#define LDS_WAIT() asm volatile("s_waitcnt lgkmcnt(0)" ::: "memory")

__device__ __forceinline__ void transpose_item(const float* W, int K, int N, int k0, int n0, bf16* dst, const float* kscale, LAS unsigned char* scr, int lane) {
    const int r = lane >> 4, c = lane & 15;
    f32x4 v[16];
#pragma unroll
    for (int j = 0; j < 8; ++j)
#pragma unroll
        for (int p = 0; p < 2; ++p) v[2 * j + p] = *(const f32x4*)(W + (size_t)(k0 + 8 * j + 2 * r + p) * N + n0 + 4 * c);
#pragma unroll
    for (int j = 0; j < 8; ++j) { const int k = 8 * j + 2 * r; float s0 = 1.0f, s1 = 1.0f; if (kscale) { const f32x2 sc = *(const f32x2*)(kscale + k0 + k); s0 = sc.x; s1 = sc.y; }
#pragma unroll
        for (int i = 0; i < 4; ++i) { const int n = 4 * c + i; *(LAS unsigned*)(scr + n * 128 + ((j ^ (c & 7)) << 4) + 4 * r) = pk2(v[2 * j][i] * s0, v[2 * j + 1][i] * s1); } }
    LDS_WAIT(); asm volatile("" ::: "memory");
    const int rr = lane >> 3, cc = lane & 7;
#pragma unroll
    for (int j = 0; j < 8; ++j) { const int n = 8 * j + rr; const v4u o = *(const LAS v4u*)(scr + n * 128 + ((cc ^ ((n >> 2) & 7)) << 4)); *(v4u*)(dst + (size_t)n * K + k0 + 8 * cc) = o; }
    LDS_WAIT(); asm volatile("" ::: "memory");
}
__device__ __forceinline__ void rms_load_gain(const float* g, f32x4 (&gg)[8], int lane) {
#pragma unroll
    for (int j = 0; j < 8; ++j) gg[j] = *(const f32x4*)(g + 256 * j + 8 * (lane & 31) + 4 * (lane >> 5));
}
__device__ __forceinline__ void rms_row_to_bf16(const float* xrow, const f32x4 (&gg)[8], bf16* orow, int lane) {
    const int lo = lane & 31, hi = lane >> 5;
    const f32x4* xr = (const f32x4*)xrow + 2 * lo + hi;
    f32x4 v[8]; float s = 0.f;
#pragma unroll
    for (int j = 0; j < 8; ++j) { v[j] = xr[64 * j]; s += (v[j].x * v[j].x + v[j].y * v[j].y) + (v[j].z * v[j].z + v[j].w * v[j].w); }
    const float rinv = 1.0f / sqrtf(wave_sum(s) * (1.f / DM) + EPS_RMS);
#pragma unroll
    for (int i = 0; i < 4; ++i) { v2u wa, wb;
        { const f32x4 x = v[2 * i], g = gg[2 * i]; wa.x = pk2(x.x * rinv * g.x, x.y * rinv * g.y); wa.y = pk2(x.z * rinv * g.z, x.w * rinv * g.w); }
        { const f32x4 x = v[2 * i + 1], g = gg[2 * i + 1]; wb.x = pk2(x.x * rinv * g.x, x.y * rinv * g.y); wb.y = pk2(x.z * rinv * g.z, x.w * rinv * g.w); }
        const auto rx = __builtin_amdgcn_permlane32_swap(wa.x, wb.x, false, false);
        const auto ry = __builtin_amdgcn_permlane32_swap(wa.y, wb.y, false, false);
        v4u w16; w16.x = rx[0]; w16.y = ry[0]; w16.z = rx[1]; w16.w = ry[1];
        *(v4u*)(orow + 256 * (2 * i + hi) + 8 * lo) = w16; }
}

struct Ptrs {
    const float *x, *norm1_g, *w_in, *q_norm_g, *k_norm_g, *lq1, *lk1, *lq2, *lk2, *subln_g, *conv_w, *conv_b, *conv_ln_g, *conv_ln_b, *w_out, *norm2_g, *w_gate, *w_up, *w_down;
    float* out;
    bf16 *Wt_in, *Wt_v, *Wt_out, *Wt_gu, *Wt_dn, *XN, *Q, *K, *VT, *U, *MIX, *ACT;
    float *COS, *SIN, *RSS, *RS;
};

__device__ __forceinline__ void p0_prologue(const Ptrs& P, LAS unsigned char* lds, int gw, int NGW, int wave, int lane) {
    LAS unsigned char* scr = lds + wave * 16384;
    constexpr int I_IN = 32 * 80, I_OUT = 32 * 32, I_G = 32 * 88, I_D = 88 * 32;
    constexpr int NITEMS = I_IN + I_OUT + 2 * I_G + I_D;
    for (int it = gw; it < NITEMS; it += NGW) {
        int r = it;
        if (r < I_IN) { const int kb = r / 80, n0 = (r % 80) * 64; bf16* dst;
            if (n0 < 2048) dst = P.Wt_in + (size_t)n0 * DM;
            else if (n0 < 3072) dst = P.Wt_v + (size_t)(n0 - 2048) * DM;
            else if (n0 < 4096) { const int ch = n0 - 3072; dst = P.Wt_in + (size_t)(2048 + (ch >> 7) * 256 + (ch & 127)) * DM; }
            else { const int ch = n0 - 4096; dst = P.Wt_in + (size_t)(2048 + (ch >> 7) * 256 + 128 + (ch & 127)) * DM; }
            transpose_item(P.w_in, DM, IN_COLS, kb * 64, n0, dst, nullptr, scr, lane); continue; }
        r -= I_IN;
        if (r < I_OUT) { const int kb = r / 32, n0 = (r % 32) * 64; transpose_item(P.w_out, DM, DM, kb * 64, n0, P.Wt_out + (size_t)n0 * DM, nullptr, scr, lane); continue; }
        r -= I_OUT;
        if (r < I_G) { const int kb = r / 88, n0 = (r % 88) * 64; transpose_item(P.w_gate, DM, FFN, kb * 64, n0, P.Wt_gu + (size_t)((n0 >> 7) * 256 + (n0 & 127)) * DM, P.norm2_g, scr, lane); continue; }
        r -= I_G;
        if (r < I_G) { const int kb = r / 88, n0 = (r % 88) * 64; transpose_item(P.w_up, DM, FFN, kb * 64, n0, P.Wt_gu + (size_t)((n0 >> 7) * 256 + 128 + (n0 & 127)) * DM, P.norm2_g, scr, lane); continue; }
        r -= I_G;
        { const int kb = r / 32, n0 = (r % 32) * 64; transpose_item(P.w_down, FFN, DM, kb * 64, n0, P.Wt_dn + (size_t)n0 * FFN, nullptr, scr, lane); }
    }
    { f32x4 gg[8]; rms_load_gain(P.norm1_g, gg, lane);
      for (int m = gw; m < M_TOK; m += NGW) rms_row_to_bf16(P.x + (size_t)m * DM, gg, P.XN + (size_t)m * DM, lane); }
    for (int i = gw * 64 + lane; i < SEQ * 64; i += NGW * 64) {
        const int pos = i >> 6, j = i & 63;
        const float inv = (float)exp2(-(double)j * (13.287712379549449 / 64.0));
        const float ang = (float)pos * inv;
        double rev = (double)ang * 0.15915494309189535; rev -= rint(rev);
        const float fr = (float)rev;
        P.COS[i] = __builtin_amdgcn_cosf(fr); P.SIN[i] = __builtin_amdgcn_sinf(fr);
    }
}

__device__ __forceinline__ void p2_qk_norm_rope(const Ptrs& P, int gw, int NGW, int lane) {
    const int sub = lane & 7, grp = lane >> 3;
    f32x4 gq[4], gk[4];
#pragma unroll
    for (int i = 0; i < 4; ++i) { const int o = sub * 8 + (i & 1) * 4 + (i >> 1) * 64; gq[i] = *(const f32x4*)(P.q_norm_g + o); gk[i] = *(const f32x4*)(P.k_norm_g + o); }
    for (int row = gw; row < M_TOK; row += NGW) {
        bf16* pq = P.Q + (size_t)row * 1024 + grp * 128 + sub * 8; bf16* pk = P.K + (size_t)row * 1024 + grp * 128 + sub * 8;
        const v4u q1 = *(const v4u*)pq, q2 = *(const v4u*)(pq + 64), k1 = *(const v4u*)pk, k2 = *(const v4u*)(pk + 64);
        const int pos = row & (SEQ - 1);
        const f32x4 c0 = *(const f32x4*)(P.COS + pos * 64 + sub * 8), c1 = *(const f32x4*)(P.COS + pos * 64 + sub * 8 + 4);
        const f32x4 s0 = *(const f32x4*)(P.SIN + pos * 64 + sub * 8), s1 = *(const f32x4*)(P.SIN + pos * 64 + sub * 8 + 4);
#pragma unroll
        for (int which = 0; which < 2; ++which) {
            const v4u r1 = which ? k1 : q1, r2 = which ? k2 : q2;
            float t1[8], t2[8];
#pragma unroll
            for (int j = 0; j < 4; ++j) { t1[2 * j] = bflo(r1[j]); t1[2 * j + 1] = bfhi(r1[j]); t2[2 * j] = bflo(r2[j]); t2[2 * j + 1] = bfhi(r2[j]); }
            float ss = 0.f;
#pragma unroll
            for (int j = 0; j < 8; ++j) ss += t1[j] * t1[j] + t2[j] * t2[j];
            ss += __shfl_xor(ss, 1); ss += __shfl_xor(ss, 2); ss += __shfl_xor(ss, 4);
            const float rinv = (1.0f / sqrtf(ss * (1.f / HD) + EPS_RMS)) * (which ? 1.0f : QSCALE);
            float o1[8], o2[8];
#pragma unroll
            for (int j = 0; j < 8; ++j) {
                const float cc = j < 4 ? c0[j & 3] : c1[j & 3], sn = j < 4 ? s0[j & 3] : s1[j & 3];
                const float ga = which ? (j < 4 ? gk[0][j & 3] : gk[1][j & 3]) : (j < 4 ? gq[0][j & 3] : gq[1][j & 3]);
                const float gb = which ? (j < 4 ? gk[2][j & 3] : gk[3][j & 3]) : (j < 4 ? gq[2][j & 3] : gq[3][j & 3]);
                const float n1 = t1[j] * rinv * ga, n2 = t2[j] * rinv * gb;
                o1[j] = n1 * cc - n2 * sn; o2[j] = n2 * cc + n1 * sn;
            }
            v4u w1, w2;
#pragma unroll
            for (int j = 0; j < 4; ++j) { w1[j] = pk2(o1[2 * j], o1[2 * j + 1]); w2[j] = pk2(o2[2 * j], o2[2 * j + 1]); }
            bf16* p = which ? pk : pq;
            *(v4u*)p = w1; *(v4u*)(p + 64) = w2;
        }
    }
}

__device__ __forceinline__ void glds16c(const void* sbase, unsigned voff, unsigned lds_dst) {
    unsigned keep;
    asm volatile("s_mov_b32 %0, m0\n\ts_mov_b32 m0, %3\n\ts_nop 0\n\tglobal_load_lds_dwordx4 %1, %2\n\ts_mov_b32 m0, %0" : "=&s"(keep) : "v"(voff), "s"(sbase), "s"(lds_dst) : "memory");
}
#define CBAR() do { LDS_WAIT(); asm volatile("" ::: "memory"); __builtin_amdgcn_s_barrier(); asm volatile("" ::: "memory"); } while (0)
#define CONV_ISSUE(item_) do { const int row0_ = (item_) * 16, s0_ = row0_ & (SEQ - 1); \
        _Pragma("nounroll") for (int k_ = 0; k_ < 12; ++k_) { const int p_ = wave + 8 * k_; if (p_ < 92) { const int r_ = p_ >> 1; const int rr_ = (s0_ - 30 + r_ < 0) ? 30 : r_; \
            glds16c((const char*)P.U + ((size_t)(row0_ - 30 + rr_) * 2048 + (size_t)(p_ & 1) * 1024), (unsigned)lane * 16u, lds0 + (unsigned)p_ * 1024u); } } } while (0)
__device__ __forceinline__ void p3_conv(const Ptrs& P, LAS unsigned char* lds, int first, int stride, int tid, int wave, int lane) {
    const int ch = 2 * tid;
    constexpr int NITEMS = M_TOK / 16, OT_OFF = 94208;
    f32x2 w[CONV_W];
#pragma unroll
    for (int k = 0; k < CONV_W; ++k) w[k] = *(const f32x2*)(P.conv_w + k * CONV_CH + ch);
    const f32x2 cb = *(const f32x2*)(P.conv_b + ch), lg = *(const f32x2*)(P.conv_ln_g + ch), lb = *(const f32x2*)(P.conv_ln_b + ch);
    LAS float* red = (LAS float*)(lds + MISC_OFF);
    LAS float* stat = red + 256;
    int bpi[6];
#pragma unroll
    for (int k = 0; k < 6; ++k) bpi[k] = (lane ^ (1 << k)) << 2;
    const unsigned lds0 = (unsigned)__builtin_amdgcn_readfirstlane((int)(unsigned)(uintptr_t)lds);
    asm volatile("s_waitcnt vmcnt(0)" ::: "memory");
#pragma unroll
    for (int k = 0; k < CONV_W; ++k) asm volatile("" : "+v"(w[k]));
    if (first < NITEMS) CONV_ISSUE(first);
    for (int item = first; item < NITEMS; item += stride) {
        const int row0 = item * 16, s0 = row0 & (SEQ - 1);
        asm volatile("s_waitcnt vmcnt(0)" ::: "memory");
        CBAR();
        unsigned uv[46];
#pragma unroll
        for (int r = 0; r < 46; ++r) { const int neg = (s0 - 30 + r) >> 31;
            uv[r] = *(const LAS unsigned*)(lds + r * 2048 + tid * 4) & ~(unsigned)neg; }
        CBAR();
        if (item + stride < NITEMS) CONV_ISSUE(item + stride);
        f32x2 a[16];
#pragma unroll
        for (int t = 0; t < 16; ++t) a[t] = cb;
#pragma unroll
        for (int r = 0; r < 46; ++r) {
            const f32x2 u = (f32x2){bflo(uv[r]), bfhi(uv[r])};
#pragma unroll
            for (int t = 0; t < 16; ++t) { const int k = r - t; if (k >= 0 && k < CONV_W) a[t] += u * w[k]; }
        }
#pragma unroll
        for (int t = 0; t < 16; ++t) {
            float s1 = a[t].x + a[t].y, s2 = a[t].x * a[t].x + a[t].y * a[t].y;
#pragma unroll
            for (int k = 0; k < 6; ++k) {
                s1 += __builtin_bit_cast(float, __builtin_amdgcn_ds_bpermute(bpi[k], __builtin_bit_cast(int, s1)));
                s2 += __builtin_bit_cast(float, __builtin_amdgcn_ds_bpermute(bpi[k], __builtin_bit_cast(int, s2)));
            }
            if (lane == 0) { red[(wave * 16 + t) * 2] = s1; red[(wave * 16 + t) * 2 + 1] = s2; }
        }
        CBAR();
        if (tid < 16) { float s1 = 0.f, s2 = 0.f;
#pragma unroll
            for (int ww = 0; ww < 8; ++ww) { s1 += red[(ww * 16 + tid) * 2]; s2 += red[(ww * 16 + tid) * 2 + 1]; }
            const float mu = s1 * (1.f / CONV_CH), var = fmaxf(s2 * (1.f / CONV_CH) - mu * mu, 0.f);
            stat[tid * 2] = mu; stat[tid * 2 + 1] = 1.0f / sqrtf(var + EPS_LN); }
        CBAR();
#pragma unroll
        for (int t = 0; t < 16; ++t) {
            const float mu = stat[t * 2], rs = stat[t * 2 + 1];
            const float y0 = (a[t].x - mu) * rs * lg.x + lb.x, y1 = (a[t].y - mu) * rs * lg.y + lb.y;
            *(LAS unsigned*)(lds + OT_OFF + t * 2048 + tid * 4) = pk2(y0 * pg8::sigmoid_fast(y0), y1 * pg8::sigmoid_fast(y1));
        }
        CBAR();
#pragma unroll
        for (int k = 0; k < 4; ++k) { const int c = tid + 512 * k; const v4u v = *(const LAS v4u*)(lds + OT_OFF + c * 16);
            *(v4u*)((char*)P.MIX + ((size_t)(row0 + (c >> 7)) * DM + ATT_W) * 2 + (size_t)(c & 127) * 16) = v; }
        CBAR();
    }
    asm volatile("s_waitcnt vmcnt(0)" ::: "memory");
}
#undef CONV_ISSUE
#undef CBAR

namespace att {
constexpr int BUF = 65536, V_OFF = 32768;
__device__ __forceinline__ void glds16(const void* sbase, unsigned voff, unsigned lds_dst) {
    unsigned keep;
    asm volatile("s_mov_b32 %0, m0\n\ts_mov_b32 m0, %3\n\ts_nop 0\n\tglobal_load_lds_dwordx4 %1, %2\n\ts_mov_b32 m0, %0" : "=&s"(keep) : "v"(voff), "s"(sbase), "s"(lds_dst) : "memory");
}
__device__ __forceinline__ int pi32(int i) { return (i & ~12) | ((i & 4) << 1) | ((i & 8) >> 1); }
#define ATT_WAIT_V(n) asm volatile("s_waitcnt vmcnt(" #n ")" ::: "memory")
#define ATT_BAR() do { asm volatile("" ::: "memory"); __builtin_amdgcn_s_barrier(); asm volatile("" ::: "memory"); } while (0)

__device__ __forceinline__ void attn_block(LAS unsigned char* lds, const Ptrs& P, int b, int h, int qb, float negMb, float lam, int tid, int wid, int lane) {
    const int comp = wid & 1, quarter = wid >> 1, l31 = lane & 31, hh = lane >> 5;
    const int NT = 2 * qb + 2;
    const size_t tok0 = (size_t)b * SEQ;
    const int qpos = qb * 128 + quarter * 32 + l31;
    bf16x8 qf[8];
    { const bf16* qp = P.Q + (tok0 + qpos) * 1024 + h * 256 + comp * 128 + hh * 8;
#pragma unroll
      for (int ks = 0; ks < 8; ++ks) qf[ks] = *(const bf16x8*)(qp + ks * 16); }
    const unsigned ldsw = (unsigned)wid * 4096u;
    const unsigned lds0 = (unsigned)__builtin_amdgcn_readfirstlane((int)(unsigned)(uintptr_t)lds);
    unsigned kb0, kx16, vb0, vy16;
    { int ln_ = lane; asm volatile("" : "+v"(ln_));
      kb0 = (unsigned)(((16 * (wid & 3) + (ln_ >> 4)) * 1024 + h * 256 + (wid >> 2) * 128) * 2); kx16 = (unsigned)(((ln_ & 15) ^ (ln_ >> 4)) << 4);
      vb0 = (unsigned)(((h * 256 + 32 * wid + (ln_ >> 3)) * M_TOK) * 2); vy16 = (unsigned)(((ln_ & 7) ^ (ln_ >> 4)) << 4);
      asm volatile("" : "+v"(kb0), "+v"(kx16), "+v"(vb0), "+v"(vy16)); }
#define ATT_DMA(t, bufi) do { const char* kb_ = (const char*)P.K + (tok0 + (size_t)(t) * 64) * 2048; const char* vb_ = (const char*)P.VT + (tok0 + (size_t)(t) * 64) * 2; \
        _Pragma("unroll") for (int pp = 0; pp < 4; ++pp) glds16(kb_, kb0 + pp * 8192 + (kx16 ^ (64 * pp)), lds0 + (bufi) * BUF + ldsw + pp * 1024); \
        _Pragma("unroll") for (int pp = 0; pp < 4; ++pp) glds16(vb_, vb0 + pp * (8 * M_TOK * 2) + (vy16 ^ (64 * (pp & 1))), lds0 + (bufi) * BUF + V_OFF + ldsw + pp * 1024); } while (0)
    f32x16 o[8];
#pragma unroll
    for (int e = 0; e < 8; ++e)
#pragma unroll
        for (int r = 0; r < 16; ++r) o[e][r] = 0.f;
    float lsum = 0.f;
    ATT_WAIT_V(0);
#pragma unroll
    for (int ks = 0; ks < 8; ++ks) asm volatile("" : "+v"(qf[ks]));
    ATT_DMA(0, 0);
    const bool early = wid < 4;
    for (int t = 0; t < NT; ++t) {
        ATT_WAIT_V(0);
        LDS_WAIT();
        ATT_BAR();
        const bool more = t + 1 < NT;
        if (more && early) ATT_DMA(t + 1, (t + 1) & 1);
        const bool active = (quarter >= 2) || more;
        const LAS unsigned char* base = lds + (t & 1) * BUF;
        int ln2 = lane; asm volatile("" : "+v"(ln2));
        const int l31b = ln2 & 31, hhb = ln2 >> 5;
        const int krow = pi32(l31b), kx = krow & 15;
        const int koffr = comp * 16384 + krow * 256;
        const int vx = (l31b >> 1) & 7;
        const int voffr = V_OFF + l31b * 128;
#pragma unroll
        for (int T = 0; T < 2; ++T) {
            if (T == 1 && more && !early) ATT_DMA(t + 1, (t + 1) & 1);
            if (active) {
                f32x16 s;
#pragma unroll
                for (int r = 0; r < 16; ++r) s[r] = negMb;
#pragma unroll
                for (int ks = 0; ks < 8; ++ks) {
                    const bf16x8 kf = *(const LAS bf16x8*)(base + koffr + T * 8192 + (((2 * ks + hhb) ^ kx) << 4));
                    s = __builtin_amdgcn_mfma_f32_32x32x16_bf16(kf, qf[ks], s, 0, 0, 0);
                }
                float ps = 0.f;
#pragma unroll
                for (int r = 0; r < 16; ++r) { s[r] = __builtin_amdgcn_exp2f(s[r]); ps += s[r]; }
                lsum += ps;
#pragma unroll
                for (int sI = 0; sI < 2; ++sI) { v4u w;
#pragma unroll
                    for (int j = 0; j < 4; ++j) w[j] = pk2(s[8 * sI + 2 * j], s[8 * sI + 2 * j + 1]);
                    const bf16x8 pf = __builtin_bit_cast(bf16x8, w);
                    const LAS unsigned char* vb = base + voffr + (((2 * (2 * T + sI) + hhb) ^ vx) << 4);
#pragma unroll
                    for (int e = 0; e < 8; ++e) {
                        const bf16x8 vf = *(const LAS bf16x8*)(vb + e * 4096);
                        o[e] = __builtin_amdgcn_mfma_f32_32x32x16_bf16(vf, pf, o[e], 0, 0, 0);
                    }
                }
            }
        }
    }
    LDS_WAIT();
    ATT_BAR();
    const float ltot = lsum + __shfl_xor(lsum, 32);
    const float inv = 1.0f / ltot;
    int ln3 = lane; asm volatile("" : "+v"(ln3));
    const int hh3 = ln3 >> 5, qpos3 = qb * 128 + quarter * 32 + (ln3 & 31);
    LAS unsigned char* xb = lds + quarter * 32768 + ln3 * 16;
    if (comp == 1) {
        const float sc = lam * inv;
#pragma unroll
        for (int e = 0; e < 8; ++e)
#pragma unroll
            for (int r4 = 0; r4 < 4; ++r4) *(LAS f32x4*)(xb + (e * 4 + r4) * 1024) = (f32x4){o[e][4 * r4] * sc, o[e][4 * r4 + 1] * sc, o[e][4 * r4 + 2] * sc, o[e][4 * r4 + 3] * sc};
    }
    LDS_WAIT();
    ATT_BAR();
    if (comp == 0) {
        float ss = 0.f;
#pragma unroll
        for (int e = 0; e < 8; ++e)
#pragma unroll
            for (int r4 = 0; r4 < 4; ++r4) { const f32x4 x1 = *(const LAS f32x4*)(xb + (e * 4 + r4) * 1024);
#pragma unroll
                for (int i = 0; i < 4; ++i) { const float v = o[e][4 * r4 + i] * inv - x1[i]; o[e][4 * r4 + i] = v; ss += v * v; } }
        ss += __shfl_xor(ss, 32);
        const float rn = (1.0f / sqrtf(ss * (1.f / VD) + EPS_RMS)) * (1.0f - LAMBDA_INIT);
        bf16* orow = P.MIX + (tok0 + qpos3) * DM + h * 256 + 8 * hh3;
        const LAS float* gp = (const LAS float*)(lds + MISC_OFF + 3072) + 4 * hh3;
#pragma unroll
        for (int e = 0; e < 8; ++e)
#pragma unroll
            for (int i2 = 0; i2 < 2; ++i2) { v2u wab[2];
#pragma unroll
                for (int q = 0; q < 2; ++q) { const int r4 = 2 * i2 + q; const f32x4 g = *(const LAS f32x4*)(gp + 32 * e + 8 * r4);
                    wab[q].x = pk2(o[e][4 * r4] * rn * g[0], o[e][4 * r4 + 1] * rn * g[1]); wab[q].y = pk2(o[e][4 * r4 + 2] * rn * g[2], o[e][4 * r4 + 3] * rn * g[3]); }
                const auto rx = __builtin_amdgcn_permlane32_swap(wab[0].x, wab[1].x, false, false);
                const auto ry = __builtin_amdgcn_permlane32_swap(wab[0].y, wab[1].y, false, false);
                v4u w16; w16.x = rx[0]; w16.y = ry[0]; w16.z = rx[1]; w16.w = ry[1];
                *(v4u*)(orow + 32 * e + 16 * i2) = w16; }
    }
    LDS_WAIT();
    ATT_BAR();
#undef ATT_DMA
}
}

#define XB_TMO      128
#define XB_XCNT(j)  (256  + 64 * (j))
#define XB_XSUB(j)  (1280 + 64 * (j))
#define XB_XGEN(j)  (2304 + 64 * (j))
#define XB_TOP      3328
#define XB_TOPGEN   3392
#define XCD_BAR_WORDS 3456
#define XB_SPIN_CAP (1u << 18)

__device__ __forceinline__ unsigned xb_ld(unsigned* p)              { return __hip_atomic_load(p, __ATOMIC_RELAXED, __HIP_MEMORY_SCOPE_AGENT); }
__device__ __forceinline__ unsigned xb_add(unsigned* p, unsigned v) { return __hip_atomic_fetch_add(p, v, __ATOMIC_RELAXED, __HIP_MEMORY_SCOPE_AGENT); }
__device__ __forceinline__ unsigned xb_xcc_id() { return (unsigned)__builtin_amdgcn_s_getreg((3 << 11) | 20) & 0xFu; }
#define XB_SPIN(cond, bar) do { unsigned _sp = 0; while (cond) { __builtin_amdgcn_s_sleep(1); \
    if ((++_sp & 255u) == 0u) { if (xb_ld(&(bar)[XB_TMO])) break; if (_sp > XB_SPIN_CAP) { atomicAdd(&(bar)[XB_TMO], 1u); break; } } } } while (0)

struct XcdBarrier {
    unsigned* bar; unsigned x;
    volatile LAS unsigned* st;
};

__device__ __forceinline__ XcdBarrier xcd_barrier_post(unsigned* bar, volatile LAS unsigned* st) {
    XcdBarrier b; b.bar = bar; b.x = xb_xcc_id(); b.st = st;
    if (threadIdx.x == 0) (void)xb_add(&bar[XB_XCNT(b.x)], 1u);
    return b;
}
__device__ __forceinline__ void xcd_barrier_complete(unsigned* bar, unsigned x, unsigned& nloc, unsigned& nx) {
    const unsigned G = gridDim.x * gridDim.y * gridDim.z;
    unsigned sum, cnt, mine, sp = 0u;
    for (;;) {
        sum = 0u; cnt = 0u; mine = 0u;
#pragma unroll
        for (unsigned j = 0; j < 16; ++j) { const unsigned c = xb_ld(&bar[XB_XCNT(j)]); sum += c; cnt += (c > 0u) ? 1u : 0u; mine = (j == x) ? c : mine; }
        if (sum == G) break;
        __builtin_amdgcn_s_sleep(1);
        if ((++sp & 255u) == 0u) { if (xb_ld(&bar[XB_TMO])) break; if (sp > XB_SPIN_CAP) { atomicAdd(&bar[XB_TMO], 1u); break; } }
    }
    nloc = mine > 0u ? mine : 1u; nx = cnt > 0u ? cnt : 1u;
}

__device__ __forceinline__ void xcd_barrier(const XcdBarrier& b) {
    asm volatile("s_waitcnt vmcnt(0)" ::: "memory");
    __syncthreads();
    if (threadIdx.x == 0) {
        unsigned* bar = b.bar;
        __builtin_amdgcn_s_waitcnt(0);
        unsigned nloc = b.st[0], nx = b.st[1];
        if (nloc == 0u) { xcd_barrier_complete(bar, b.x, nloc, nx); b.st[0] = nloc; b.st[1] = nx; }
        const unsigned old = xb_add(&bar[XB_XSUB(b.x)], 1u);
        const unsigned gen = old / nloc;
        if (old + 1u == (gen + 1u) * nloc) {
            __builtin_amdgcn_fence(__ATOMIC_RELEASE, "agent");
            asm volatile("s_waitcnt vmcnt(0)" ::: "memory");
            const unsigned og = xb_add(&bar[XB_TOP], 1u);
            const unsigned tg = og / nx;
            if (og + 1u == (tg + 1u) * nx) xb_add(&bar[XB_TOPGEN], 1u);
            else XB_SPIN(xb_ld(&bar[XB_TOPGEN]) == tg, bar);
            __builtin_amdgcn_fence(__ATOMIC_ACQUIRE, "agent");
            xb_add(&bar[XB_XGEN(b.x)], 1u);
            asm volatile("s_waitcnt vmcnt(0)" ::: "memory");
        } else {
            XB_SPIN(xb_ld(&bar[XB_XGEN(b.x)]) == gen, bar);
            __builtin_amdgcn_fence(__ATOMIC_ACQUIRE, "agent");
            asm volatile("s_waitcnt vmcnt(0)" ::: "memory");
        }
    }
    __syncthreads();
}

struct Args { const float* in[19]; float* out; unsigned char* ws; int ph_lo, ph_hi; };
constexpr int N_PHASES = 8;

__global__ void __launch_bounds__(NTHREADS) mega_fwd(Args args) {
    extern __shared__ __attribute__((aligned(16))) unsigned char lds_raw[];
    LAS unsigned char* lds = (LAS unsigned char*)lds_raw;
    const int tid = threadIdx.x, lane = tid & 63, wave = __builtin_amdgcn_readfirstlane(tid >> 6);
    const int G = gridDim.x, bx = blockIdx.x;
    const int vcu = (G % 8 == 0) ? (bx % 8) * (G / 8) + bx / 8 : bx;
    const int gw = vcu * NWAVES + wave, NGW = G * NWAVES;
    unsigned char* ws = args.ws;
#define MAKE_P() Ptrs P; { unsigned char* w_ = args.ws; asm volatile("" : "+s"(w_)); \
    P.x = args.in[0]; P.norm1_g = args.in[1]; P.w_in = args.in[2]; P.q_norm_g = args.in[3]; P.k_norm_g = args.in[4]; P.lq1 = args.in[5]; P.lk1 = args.in[6]; P.lq2 = args.in[7]; P.lk2 = args.in[8]; \
    P.subln_g = args.in[9]; P.conv_w = args.in[10]; P.conv_b = args.in[11]; P.conv_ln_g = args.in[12]; P.conv_ln_b = args.in[13]; P.w_out = args.in[14]; P.norm2_g = args.in[15]; \
    P.w_gate = args.in[16]; P.w_up = args.in[17]; P.w_down = args.in[18]; P.out = args.out; \
    P.Wt_in = (bf16*)(w_ + WS_WIN); P.Wt_v = (bf16*)(w_ + WS_WV); P.Wt_out = (bf16*)(w_ + WS_WOUT); P.Wt_gu = (bf16*)(w_ + WS_WGU); P.Wt_dn = (bf16*)(w_ + WS_WDN); \
    P.XN = (bf16*)(w_ + WS_XN); P.Q = (bf16*)(w_ + WS_Q); P.K = (bf16*)(w_ + WS_K); P.VT = (bf16*)(w_ + WS_VT); P.U = (bf16*)(w_ + WS_U); P.MIX = (bf16*)(w_ + WS_MIX); P.ACT = (bf16*)(w_ + WS_ACT); \
    P.COS = (float*)(w_ + WS_COS); P.SIN = (float*)(w_ + WS_SIN); P.RSS = (float*)(w_ + WS_RSS); P.RS = (float*)(w_ + WS_RS); }
    const int lo = args.ph_lo, hi = args.ph_hi;
    if (tid < 2) ((volatile LAS unsigned*)(lds + BARST_OFF))[tid] = 0u;
    __syncthreads();
    XcdBarrier gbar = xcd_barrier_post((unsigned*)(ws + WS_BAR), (volatile LAS unsigned*)(lds + BARST_OFF));
#ifndef PHASE_MASK
#define PHASE_MASK 0xff
#endif
#define IN(k) (((PHASE_MASK >> (k)) & 1) && lo <= (k) && (k) < hi)
#ifndef REP3
#define REP3 1
#endif
#ifndef REP6
#define REP6 1
#endif
#ifndef REP1
#define REP1 1
#endif
#define SEAM(k) do { if (IN(k) && IN((k) + 1)) { if (args.ph_hi > 1000) cooperative_groups::this_grid().sync(); else xcd_barrier(gbar); } } while (0)

    if (IN(0)) { MAKE_P(); p0_prologue(P, lds, gw, NGW, wave, lane); }
    SEAM(0);
    if (IN(1)) {
        MAKE_P();
        { pg8::Gemm g{P.XN, P.Wt_in, M_TOK, 4096, DM}; pg8::StaticOrder S; S.init(M_TOK, 4096, G, bx); S.rep = REP1; pg8::EpiProj E{P.Q, P.K, P.U};
          pg8::gemm_phase<pg8::EpiProj, pg8::StaticOrder, true, true>(lds, g, S, E); }
        { pg8::Gemm g{P.Wt_v, P.XN, 1024, M_TOK, DM}; pg8::StaticOrder S; S.init(1024, M_TOK, G, bx); pg8::EpiPlain E{P.VT, M_TOK};
          pg8::gemm_phase<pg8::EpiPlain, pg8::StaticOrder, true, true>(lds, g, S, E); }
    }
    SEAM(1);
    if (IN(2)) { MAKE_P(); p2_qk_norm_rope(P, gw, NGW, lane); }
    SEAM(2);
    if (IN(3)) {
        MAKE_P();
#ifndef NO_CONV
        p3_conv(P, lds, bx, G, tid, wave, lane);
#endif
        float lam, negMb;
        { const float a = P.lq1[lane] * P.lk1[lane] + P.lq1[lane + 64] * P.lk1[lane + 64], c = P.lq2[lane] * P.lk2[lane] + P.lq2[lane + 64] * P.lk2[lane + 64];
          lam = expf(wave_sum(a)) - expf(wave_sum(c)) + LAMBDA_INIT;
          const float gq = wave_max(fmaxf(fabsf(P.q_norm_g[lane]), fabsf(P.q_norm_g[lane + 64]))), gk = wave_max(fmaxf(fabsf(P.k_norm_g[lane]), fabsf(P.k_norm_g[lane + 64])));
          negMb = -(gq * gk * 11.313708498984761f * 1.4426950408889634f * 1.01f);
          lam = __builtin_bit_cast(float, __builtin_amdgcn_readfirstlane(__builtin_bit_cast(int, lam))); negMb = __builtin_bit_cast(float, __builtin_amdgcn_readfirstlane(__builtin_bit_cast(int, negMb))); }
#ifndef NO_ATT
        if (tid < 64) *(LAS f32x4*)(lds + MISC_OFF + 3072 + tid * 16) = *(const f32x4*)(P.subln_g + tid * 4);
        __syncthreads();
        for (int item = vcu; item < 512; item += G) {
            const int bh = item >> 5, pair = item & 31;
            for (int half = 0; half < 2 * REP3; ++half)
                att::attn_block(lds, P, bh >> 2, bh & 3, (half & 1) ? pair : 63 - pair, negMb, lam, tid, wave, lane);
        }
#endif
    }
    SEAM(3);
    if (IN(4)) { MAKE_P(); pg8::Gemm g{P.MIX, P.Wt_out, M_TOK, DM, DM}; pg8::StaticOrder S; S.init(M_TOK, DM, G, bx); pg8::EpiResNorm2 E{P.x, P.out, P.XN, P.RSS, DM, (LAS float*)(lds + MISC_OFF)};
        pg8::gemm_phase<pg8::EpiResNorm2, pg8::StaticOrder, true, true>(lds, g, S, E); }
    SEAM(4);
    if (IN(5)) { MAKE_P(); const int i = (vcu * NWAVES + wave) * 64 + lane;
        if (i < M_TOK) { const f32x4 p0 = *(const f32x4*)(P.RSS + (size_t)i * 8), p1 = *(const f32x4*)(P.RSS + (size_t)i * 8 + 4);
            P.RS[i] = 1.0f / sqrtf((((p0[0] + p0[1]) + (p0[2] + p0[3])) + ((p1[0] + p1[1]) + (p1[2] + p1[3]))) * (1.0f / DM) + EPS_RMS); } }
    SEAM(5);
    if (IN(6)) { MAKE_P(); pg8::Gemm g{P.XN, P.Wt_gu, M_TOK, 2 * FFN, DM}; pg8::OrderRs S; S.init(M_TOK, 2 * FFN, G, bx); S.rsv = P.RS; S.wr_ = wave >> 2; S.lane_ = lane; S.a0 = S.a1 = S.b0 = S.b1 = 0.f; S.n_ready = 0; pg8::EpiSwiGLUP E{P.ACT, FFN, &S, 0};
        pg8::gemm_phase<pg8::EpiSwiGLUP, pg8::OrderRs, true, true>(lds, g, S, E); }
    SEAM(6);
    if (IN(7)) { MAKE_P(); pg8::Gemm g{P.ACT, P.Wt_dn, M_TOK, DM, FFN}; pg8::StaticOrder S; S.init(M_TOK, DM, G, bx); pg8::EpiResB E{P.XN, P.out, DM};
        pg8::gemm_phase<pg8::EpiResB, pg8::StaticOrder, true, true>(lds, g, S, E); }
#undef IN
#undef SEAM
}

#ifndef MK_MULTI
#define MK_MULTI 0
#endif
extern "C" void kernel_launch(void* const* d_in, const int* in_sizes, int n_in, void* d_out, int out_size, void* d_ws, size_t ws_size, hipStream_t stream) {
    static int grid = 0;
    if (grid == 0) {
        if (n_in != 19 || ws_size < WS_END) { fprintf(stderr, "kernel_launch: unexpected n_in %d / ws %zu\n", n_in, ws_size); grid = -1; return; }
        int dev = 0, cus = 0, per_cu = 0;
        hipGetDevice(&dev); hipDeviceGetAttribute(&cus, hipDeviceAttributeMultiprocessorCount, dev);
        if (hipFuncSetAttribute((const void*)mega_fwd, hipFuncAttributeMaxDynamicSharedMemorySize, LDS_BYTES) != hipSuccess) { fprintf(stderr, "kernel_launch: hipFuncSetAttribute failed\n"); }
        if (hipOccupancyMaxActiveBlocksPerMultiprocessor(&per_cu, (const void*)mega_fwd, NTHREADS, LDS_BYTES) != hipSuccess || per_cu < 1) { fprintf(stderr, "kernel_launch: occupancy query says %d\n", per_cu); per_cu = 1; }
        (void)hipGetLastError();
        grid = cus * per_cu;
        fprintf(stderr, "kernel_launch: grid %d (cus %d x %d)\n", grid, cus, per_cu);
    }
    if (grid < 0) return;
    if (hipMemsetAsync((char*)d_ws + WS_BAR, 0, BAR_ZERO_BYTES, stream) != hipSuccess) { fprintf(stderr, "kernel_launch: hipMemsetAsync failed\n"); return; }
    Args a{};
    for (int i = 0; i < 19; ++i) a.in[i] = (const float*)d_in[i];
    a.out = (float*)d_out; a.ws = (unsigned char*)d_ws;
#if MK_MULTI
    for (int ph = 0; ph < N_PHASES; ++ph) { a.ph_lo = ph; a.ph_hi = ph + 1; hipLaunchKernelGGL(mega_fwd, dim3(grid), dim3(NTHREADS), LDS_BYTES, stream, a); }
#else
    a.ph_lo = 0; a.ph_hi = N_PHASES;
    void* kargs[] = {(void*)&a};
    hipError_t e = hipLaunchCooperativeKernel((const void*)mega_fwd, dim3(grid), dim3(NTHREADS), kargs, LDS_BYTES, stream);
    if (e != hipSuccess) fprintf(stderr, "kernel_launch: cooperative launch failed: %s (grid %d)\n", hipGetErrorString(e), grid);
#endif
}
```

```cpp
#include <hip/hip_runtime.h>
#include <hip/hip_cooperative_groups.h>
#include <cstdio>
#include <cstdint>
namespace pg8 {
#define PG8_LAS __attribute__((address_space(3)))
typedef unsigned short bf16_t;
typedef short bf16x8 __attribute__((ext_vector_type(8)));
typedef float f32x4 __attribute__((ext_vector_type(4)));
typedef unsigned u32x4 __attribute__((ext_vector_type(4)));
constexpr int BM = 256, BK = 64, HALF = 128, HTB = HALF * BK * 2  , STAGE_BYTES = 8 * HTB, NXCD = 8, WGM = 8;

__host__ __device__ __forceinline__ int lds_byte(int r, int c) { const int st = (r >> 4) * 2 + (c >> 5), rr = r & 15, cc = c & 31, ob = rr * 64 + cc * 2; return st * 1024 + (ob ^ (((ob >> 9) & 1) << 5)); }
__host__ __device__ __forceinline__ void stage_rc(int b, int& R, int& C) { const int st = b / 1024, sb = b % 1024, swz = sb ^ (((sb >> 9) & 1) << 5); R = (st >> 1) * 16 + swz / 64; C = (st & 1) * 32 + (swz % 64) / 2; }
__host__ __device__ __forceinline__ int perm32(int rho) { const int n = rho >> 4, i = rho & 15; return 8 * (i >> 2) + 4 * n + (i & 3); }

struct Unit { int pm, pn; };
struct Gemm { const bf16_t* A; const bf16_t* Bt; int M, N, K; };

struct StaticOrder {
    int nM, nN, nwg, G, c, rep;
    __host__ __device__ void init(int M, int N, int G_, int c_) { nM = M / BM; nN = N / BM; nwg = nM * nN; G = G_; c = c_; rep = 1; }
    __host__ __device__ bool next(int i, Unit& u) const {
        if (rep > 1) { const int cnt = (nwg - c + G - 1) / G; if (i >= cnt * rep) return false; i = i % cnt; }
        const long L = (long)i * G + c; if (L >= nwg) return false;
        int wgid = (int)L; { const int q = nwg / NXCD, r = nwg % NXCD, xcd = wgid % NXCD, off = wgid / NXCD; wgid = (xcd < r ? xcd * (q + 1) : r * (q + 1) + (xcd - r) * q) + off; }
        const int nig = WGM * nN, gid = wgid / nig, fm = gid * WGM, gsz = (nM - fm) < WGM ? (nM - fm) : WGM;
        u.pm = fm + ((wgid % nig) % gsz); u.pn = (wgid % nig) / gsz; return true;
    }
    __device__ __forceinline__ void a_ready(const Unit&) const {}
    __device__ __forceinline__ void done(const Unit&) const {}
};

__device__ __forceinline__ unsigned cvt_pk_bf16(float lo, float hi) { unsigned r; asm volatile("v_cvt_pk_bf16_f32 %0, %1, %2" : "=v"(r) : "v"(lo), "v"(hi)); return r; }
typedef float f32x2 __attribute__((ext_vector_type(2)));
__device__ __forceinline__ float sigmoid_fast(float x) { return __builtin_amdgcn_rcpf(1.0f + __builtin_amdgcn_exp2f(-1.4426950408889634f * x)); }
__device__ __forceinline__ u32x4 pack8(const f32x4 v0, const f32x4 v1) { u32x4 w; w.x = cvt_pk_bf16(v0[0], v0[1]); w.y = cvt_pk_bf16(v0[2], v0[3]); w.z = cvt_pk_bf16(v1[0], v1[1]); w.w = cvt_pk_bf16(v1[2], v1[3]); return w; }

struct EpiProj {
    static constexpr bool PERM = true, AFTER_DRAIN = false;
    bf16_t *Q, *K, *U;
    __device__ __forceinline__ void operator()(const f32x4 (&acc)[2][2][4][2], const Unit& u, int wr, int wc, int fr, int fq) const {
        const int row0 = u.pm * BM + wr * 64 + fr;
        if (u.pn < 8) {
            bf16_t* base = (u.pn < 4 ? Q : K) + (u.pn & 3) * 256 + wc * 32 + 8 * fq;
#pragma unroll
            for (int ai = 0; ai < 2; ++ai)
#pragma unroll
                for (int m = 0; m < 4; ++m) { bf16_t* rowp = base + (size_t)(row0 + ai * HALF + m * 16) * 1024;
#pragma unroll
                    for (int bj = 0; bj < 2; ++bj) *(u32x4*)(rowp + bj * HALF) = pack8(acc[ai][bj][m][0], acc[ai][bj][m][1]); }
        } else {
            bf16_t* base = U + (u.pn - 8) * 128 + wc * 32 + 8 * fq;
#pragma unroll
            for (int ai = 0; ai < 2; ++ai)
#pragma unroll
                for (int m = 0; m < 4; ++m) { bf16_t* rowp = base + (size_t)(row0 + ai * HALF + m * 16) * 1024;
                    f32x4 v[2];
#pragma unroll
                    for (int n = 0; n < 2; ++n) { const f32x4 a = acc[ai][0][m][n], g = acc[ai][1][m][n];
                        v[n] = (f32x4){a[0] * sigmoid_fast(g[0]), a[1] * sigmoid_fast(g[1]), a[2] * sigmoid_fast(g[2]), a[3] * sigmoid_fast(g[3])}; }
                    *(u32x4*)rowp = pack8(v[0], v[1]); }
        }
    }
};
struct EpiPlain {
    static constexpr bool PERM = true, AFTER_DRAIN = false;
    bf16_t* O; int ldc;
    __device__ __forceinline__ void operator()(const f32x4 (&acc)[2][2][4][2], const Unit& u, int wr, int wc, int fr, int fq) const {
        const int row0 = u.pm * BM + wr * 64 + fr; bf16_t* base = O + u.pn * BM + wc * 32 + 8 * fq;
#pragma unroll
        for (int ai = 0; ai < 2; ++ai)
#pragma unroll
            for (int m = 0; m < 4; ++m) { bf16_t* rowp = base + (size_t)(row0 + ai * HALF + m * 16) * ldc;
#pragma unroll
                for (int bj = 0; bj < 2; ++bj) *(u32x4*)(rowp + bj * HALF) = pack8(acc[ai][bj][m][0], acc[ai][bj][m][1]); }
    }
};
struct EpiSwiGLU {
    static constexpr bool PERM = true, AFTER_DRAIN = false;
    bf16_t* O; int ldc;
    __device__ __forceinline__ void operator()(const f32x4 (&acc)[2][2][4][2], const Unit& u, int wr, int wc, int fr, int fq) const {
        const int row0 = u.pm * BM + wr * 64 + fr; bf16_t* base = O + u.pn * 128 + wc * 32 + 8 * fq;
#pragma unroll
        for (int ai = 0; ai < 2; ++ai)
#pragma unroll
            for (int m = 0; m < 4; ++m) { bf16_t* rowp = base + (size_t)(row0 + ai * HALF + m * 16) * ldc;
                f32x4 v[2];
#pragma unroll
                for (int n = 0; n < 2; ++n) { const f32x4 a = acc[ai][0][m][n], b = acc[ai][1][m][n];
                    v[n] = (f32x4){a[0] * sigmoid_fast(a[0]) * b[0], a[1] * sigmoid_fast(a[1]) * b[1], a[2] * sigmoid_fast(a[2]) * b[2], a[3] * sigmoid_fast(a[3]) * b[3]}; }
                *(u32x4*)rowp = pack8(v[0], v[1]); }
    }
};
struct EpiSwiGLUN {
    static constexpr bool PERM = true, AFTER_DRAIN = false;
    bf16_t* O; int ldc; const float* rss;
    __device__ __forceinline__ void operator()(const f32x4 (&acc)[2][2][4][2], const Unit& u, int wr, int wc, int fr, int fq) const {
        const int row0 = u.pm * BM + wr * 64 + fr; bf16_t* base = O + u.pn * 128 + wc * 32 + 8 * fq;
#pragma unroll
        for (int ai = 0; ai < 2; ++ai)
#pragma unroll
            for (int m = 0; m < 4; ++m) { const int row = row0 + ai * HALF + m * 16; bf16_t* rowp = base + (size_t)row * ldc;
                const f32x4 p0 = *(const f32x4*)(rss + (size_t)row * 8), p1 = *(const f32x4*)(rss + (size_t)row * 8 + 4);
                const float rs = 1.0f / sqrtf((((p0[0] + p0[1]) + (p0[2] + p0[3])) + ((p1[0] + p1[1]) + (p1[2] + p1[3]))) * (1.0f / 2048.0f) + 1e-6f);
                f32x4 v[2];
#pragma unroll
                for (int n = 0; n < 2; ++n) { const f32x4 a = acc[ai][0][m][n] * rs, b = acc[ai][1][m][n] * rs;
                    v[n] = (f32x4){a[0] * sigmoid_fast(a[0]) * b[0], a[1] * sigmoid_fast(a[1]) * b[1], a[2] * sigmoid_fast(a[2]) * b[2], a[3] * sigmoid_fast(a[3]) * b[3]}; }
                *(u32x4*)rowp = pack8(v[0], v[1]); }
    }
};
struct EpiSwiGLUR {
    static constexpr bool PERM = true, AFTER_DRAIN = false;
    bf16_t* O; int ldc; const float* rsv;
    __device__ __forceinline__ void operator()(const f32x4 (&acc)[2][2][4][2], const Unit& u, int wr, int wc, int fr, int fq) const {
        const int row0 = u.pm * BM + wr * 64 + fr; bf16_t* base = O + u.pn * 128 + wc * 32 + 8 * fq;
        float rs8[8];
#pragma unroll
        for (int i = 0; i < 8; ++i) rs8[i] = rsv[row0 + (i >> 2) * HALF + (i & 3) * 16];
#pragma unroll
        for (int ai = 0; ai < 2; ++ai)
#pragma unroll
            for (int m = 0; m < 4; ++m) { const int row = row0 + ai * HALF + m * 16; bf16_t* rowp = base + (size_t)row * ldc; const float rs = rs8[ai * 4 + m];
                f32x4 v[2];
#pragma unroll
                for (int n = 0; n < 2; ++n) { const f32x4 a = acc[ai][0][m][n] * rs, b = acc[ai][1][m][n] * rs;
                    v[n] = (f32x4){a[0] * sigmoid_fast(a[0]) * b[0], a[1] * sigmoid_fast(a[1]) * b[1], a[2] * sigmoid_fast(a[2]) * b[2], a[3] * sigmoid_fast(a[3]) * b[3]}; }
                *(u32x4*)rowp = pack8(v[0], v[1]); }
    }
};
struct EpiResNorm {
    static constexpr bool PERM = false, AFTER_DRAIN = false;
    const float* base; float* out; bf16_t* hb; float* rss; int ldc; PG8_LAS float* red;
    __device__ __forceinline__ void operator()(const f32x4 (&acc)[2][2][4][2], const Unit& u, int wr, int wc, int fr, int fq) const {
        const int row0 = u.pm * BM + wr * 64 + fr, col0 = u.pn * BM + wc * 32 + 4 * fq;
#pragma unroll
        for (int ai = 0; ai < 2; ++ai)
#pragma unroll
            for (int m = 0; m < 4; ++m) { const int row = row0 + ai * HALF + m * 16; const size_t off = (size_t)row * ldc + col0; float ss = 0.f;
#pragma unroll
                for (int bj = 0; bj < 2; ++bj)
#pragma unroll
                    for (int n = 0; n < 2; ++n) { const f32x4 h = *(const f32x4*)(base + off + bj * HALF + n * 16) + acc[ai][bj][m][n];
                        *(f32x4*)(out + off + bj * HALF + n * 16) = h; ss += (h[0] * h[0] + h[1] * h[1]) + (h[2] * h[2] + h[3] * h[3]);
                        unsigned long long w = (unsigned long long)cvt_pk_bf16(h[0], h[1]) | ((unsigned long long)cvt_pk_bf16(h[2], h[3]) << 32);
                        *(unsigned long long*)(hb + off + bj * HALF + n * 16) = w; }
                ss += __shfl_xor(ss, 16); ss += __shfl_xor(ss, 32);
                if (fq == 0) red[(ai * HALF + wr * 64 + m * 16 + fr) * 4 + wc] = ss; }
        asm volatile("s_waitcnt lgkmcnt(0)" ::: "memory"); __builtin_amdgcn_s_barrier(); asm volatile("" ::: "memory");
        { const int t = threadIdx.x; if (t < 256) { const f32x4 p = *(const PG8_LAS f32x4*)(red + t * 4); rss[(size_t)(u.pm * BM + t) * 8 + u.pn] = (p[0] + p[1]) + (p[2] + p[3]); } }
        asm volatile("s_waitcnt lgkmcnt(0)" ::: "memory"); __builtin_amdgcn_s_barrier(); asm volatile("" ::: "memory");
    }
};
struct OrderRs : StaticOrder {
    const float* rsv; int wr_, lane_;
    mutable float a0, a1, b0, b1; mutable int n_ready;
    __device__ __forceinline__ void a_ready(const Unit& u) const {
        const float* p = rsv + u.pm * BM + wr_ * 64 + lane_;
        if (n_ready & 1) { b0 = p[0]; b1 = p[HALF]; } else { a0 = p[0]; a1 = p[HALF]; }
        ++n_ready;
    }
};
struct EpiSwiGLUP {
    static constexpr bool PERM = true, AFTER_DRAIN = false;
    bf16_t* O; int ldc; const OrderRs* S; mutable int n_done;
    __device__ __forceinline__ void operator()(const f32x4 (&acc)[2][2][4][2], const Unit& u, int wr, int wc, int fr, int fq) const {
        const int row0 = u.pm * BM + wr * 64 + fr; bf16_t* base = O + u.pn * 128 + wc * 32 + 8 * fq;
        const bool par = (n_done & 1) != 0; ++n_done;
        const float r0 = par ? S->b0 : S->a0, r1 = par ? S->b1 : S->a1;
#pragma unroll
        for (int ai = 0; ai < 2; ++ai)
#pragma unroll
            for (int m = 0; m < 4; ++m) { const int row = row0 + ai * HALF + m * 16; bf16_t* rowp = base + (size_t)row * ldc;
                const float rs = __builtin_bit_cast(float, __builtin_amdgcn_ds_bpermute((m * 16 + fr) << 2, __builtin_bit_cast(int, ai ? r1 : r0)));
                f32x4 v[2];
#pragma unroll
                for (int n = 0; n < 2; ++n) { const f32x4 a = acc[ai][0][m][n] * rs, b = acc[ai][1][m][n] * rs;
                    v[n] = (f32x4){a[0] * sigmoid_fast(a[0]) * b[0], a[1] * sigmoid_fast(a[1]) * b[1], a[2] * sigmoid_fast(a[2]) * b[2], a[3] * sigmoid_fast(a[3]) * b[3]}; }
                *(u32x4*)rowp = pack8(v[0], v[1]); }
    }
};
struct EpiResNorm2 {
    static constexpr bool PERM = true, AFTER_DRAIN = false;
    const float* base; float* out; bf16_t* hb; float* rss; int ldc; PG8_LAS float* red;
    __device__ __forceinline__ void operator()(const f32x4 (&acc)[2][2][4][2], const Unit& u, int wr, int wc, int fr, int fq) const {
        const int row0 = u.pm * BM + wr * 64 + fr, col0 = u.pn * BM + wc * 32 + 8 * fq;
#pragma unroll
        for (int ai = 0; ai < 2; ++ai)
#pragma unroll
            for (int m = 0; m < 4; ++m) { const int row = row0 + ai * HALF + m * 16; const size_t off = (size_t)row * ldc + col0; float ss = 0.f;
#pragma unroll
                for (int bj = 0; bj < 2; ++bj) { const f32x4 h0 = *(const f32x4*)(base + off + bj * HALF) + acc[ai][bj][m][0], h1 = *(const f32x4*)(base + off + bj * HALF + 4) + acc[ai][bj][m][1];
                    ss += ((h0[0] * h0[0] + h0[1] * h0[1]) + (h0[2] * h0[2] + h0[3] * h0[3])) + ((h1[0] * h1[0] + h1[1] * h1[1]) + (h1[2] * h1[2] + h1[3] * h1[3]));
                    *(u32x4*)(hb + off + bj * HALF) = pack8(h0, h1); }
                ss += __shfl_xor(ss, 16); ss += __shfl_xor(ss, 32);
                if (fq == 0) red[(ai * HALF + wr * 64 + m * 16 + fr) * 4 + wc] = ss; }
        asm volatile("s_waitcnt lgkmcnt(0)" ::: "memory"); __builtin_amdgcn_s_barrier(); asm volatile("" ::: "memory");
        { const int t = threadIdx.x; if (t < 256) { const f32x4 p = *(const PG8_LAS f32x4*)(red + t * 4); rss[(size_t)(u.pm * BM + t) * 8 + u.pn] = (p[0] + p[1]) + (p[2] + p[3]); } }
        asm volatile("s_waitcnt lgkmcnt(0)" ::: "memory"); __builtin_amdgcn_s_barrier(); asm volatile("" ::: "memory");
    }
};
struct EpiProjP {
    static constexpr bool PERM = true, AFTER_DRAIN = false;
    bf16_t *Q, *K, *U; const OrderRs* S; mutable int n_done;
    __device__ __forceinline__ void operator()(const f32x4 (&acc)[2][2][4][2], const Unit& u, int wr, int wc, int fr, int fq) const {
        const int row0 = u.pm * BM + wr * 64 + fr;
        const bool par = (n_done & 1) != 0; ++n_done;
        const float r0 = par ? S->b0 : S->a0, r1 = par ? S->b1 : S->a1;
        float rs8[8];
#pragma unroll
        for (int i = 0; i < 8; ++i) rs8[i] = __builtin_bit_cast(float, __builtin_amdgcn_ds_bpermute(((i & 3) * 16 + fr) << 2, __builtin_bit_cast(int, (i >> 2) ? r1 : r0)));
        if (u.pn < 8) {
            bf16_t* base = (u.pn < 4 ? Q : K) + (u.pn & 3) * 256 + wc * 32 + 8 * fq;
#pragma unroll
            for (int ai = 0; ai < 2; ++ai)
#pragma unroll
                for (int m = 0; m < 4; ++m) { bf16_t* rowp = base + (size_t)(row0 + ai * HALF + m * 16) * 1024; const float rs = rs8[ai * 4 + m];
#pragma unroll
                    for (int bj = 0; bj < 2; ++bj) *(u32x4*)(rowp + bj * HALF) = pack8(acc[ai][bj][m][0] * rs, acc[ai][bj][m][1] * rs); }
        } else {
            bf16_t* base = U + (u.pn - 8) * 128 + wc * 32 + 8 * fq;
#pragma unroll
            for (int ai = 0; ai < 2; ++ai)
#pragma unroll
                for (int m = 0; m < 4; ++m) { bf16_t* rowp = base + (size_t)(row0 + ai * HALF + m * 16) * 1024; const float rs = rs8[ai * 4 + m];
                    f32x4 v[2];
#pragma unroll
                    for (int n = 0; n < 2; ++n) { const f32x4 a = acc[ai][0][m][n] * rs, g = acc[ai][1][m][n] * rs;
                        v[n] = (f32x4){a[0] * sigmoid_fast(g[0]), a[1] * sigmoid_fast(g[1]), a[2] * sigmoid_fast(g[2]), a[3] * sigmoid_fast(g[3])}; }
                    *(u32x4*)rowp = pack8(v[0], v[1]); }
        }
    }
};
struct EpiPlainC {
    static constexpr bool PERM = true, AFTER_DRAIN = false;
    bf16_t* O; int ldc; const float* rsv;
    __device__ __forceinline__ void operator()(const f32x4 (&acc)[2][2][4][2], const Unit& u, int wr, int wc, int fr, int fq) const {
        const int row0 = u.pm * BM + wr * 64 + fr, col0 = u.pn * BM + wc * 32 + 8 * fq; bf16_t* base = O + col0;
        f32x4 rc[2][2];
#pragma unroll
        for (int bj = 0; bj < 2; ++bj)
#pragma unroll
            for (int n = 0; n < 2; ++n) rc[bj][n] = *(const f32x4*)(rsv + col0 + bj * HALF + 4 * n);
#pragma unroll
        for (int ai = 0; ai < 2; ++ai)
#pragma unroll
            for (int m = 0; m < 4; ++m) { bf16_t* rowp = base + (size_t)(row0 + ai * HALF + m * 16) * ldc;
#pragma unroll
                for (int bj = 0; bj < 2; ++bj) *(u32x4*)(rowp + bj * HALF) = pack8(acc[ai][bj][m][0] * rc[bj][0], acc[ai][bj][m][1] * rc[bj][1]); }
    }
};
struct EpiResNorm3 {
    static constexpr bool PERM = true, AFTER_DRAIN = false;
    bf16_t* hb; float* rss; int ldc; PG8_LAS float* red;
    __device__ __forceinline__ void operator()(const f32x4 (&acc)[2][2][4][2], const Unit& u, int wr, int wc, int fr, int fq) const {
        const int row0 = u.pm * BM + wr * 64 + fr, col0 = u.pn * BM + wc * 32 + 8 * fq;
#pragma unroll
        for (int ai = 0; ai < 2; ++ai)
#pragma unroll
            for (int m = 0; m < 4; ++m) { const int row = row0 + ai * HALF + m * 16; const size_t off = (size_t)row * ldc + col0; float ss = 0.f;
#pragma unroll
                for (int bj = 0; bj < 2; ++bj) { const u32x4 w = *(const u32x4*)(hb + off + bj * HALF);
                    const f32x4 x0 = {__builtin_bit_cast(float, w.x << 16), __builtin_bit_cast(float, w.x & 0xffff0000u), __builtin_bit_cast(float, w.y << 16), __builtin_bit_cast(float, w.y & 0xffff0000u)};
                    const f32x4 x1 = {__builtin_bit_cast(float, w.z << 16), __builtin_bit_cast(float, w.z & 0xffff0000u), __builtin_bit_cast(float, w.w << 16), __builtin_bit_cast(float, w.w & 0xffff0000u)};
                    const f32x4 h0 = x0 + acc[ai][bj][m][0], h1 = x1 + acc[ai][bj][m][1];
                    ss += ((h0[0] * h0[0] + h0[1] * h0[1]) + (h0[2] * h0[2] + h0[3] * h0[3])) + ((h1[0] * h1[0] + h1[1] * h1[1]) + (h1[2] * h1[2] + h1[3] * h1[3]));
                    *(u32x4*)(hb + off + bj * HALF) = pack8(h0, h1); }
                ss += __shfl_xor(ss, 16); ss += __shfl_xor(ss, 32);
                if (fq == 0) red[(ai * HALF + wr * 64 + m * 16 + fr) * 4 + wc] = ss; }
        asm volatile("s_waitcnt lgkmcnt(0)" ::: "memory"); __builtin_amdgcn_s_barrier(); asm volatile("" ::: "memory");
        { const int t = threadIdx.x; if (t < 256) { const f32x4 p = *(const PG8_LAS f32x4*)(red + t * 4); rss[(size_t)(u.pm * BM + t) * 8 + u.pn] = (p[0] + p[1]) + (p[2] + p[3]); } }
        asm volatile("s_waitcnt lgkmcnt(0)" ::: "memory"); __builtin_amdgcn_s_barrier(); asm volatile("" ::: "memory");
    }
};
struct EpiResB {
    static constexpr bool PERM = true, AFTER_DRAIN = false;
    const bf16_t* hb; float* out; int ldc;
    __device__ __forceinline__ void operator()(const f32x4 (&acc)[2][2][4][2], const Unit& u, int wr, int wc, int fr, int fq) const {
        const int row0 = u.pm * BM + wr * 64 + fr, col0 = u.pn * BM + wc * 32 + 8 * fq;
#pragma unroll
        for (int ai = 0; ai < 2; ++ai)
#pragma unroll
            for (int m = 0; m < 4; ++m) { const size_t off = (size_t)(row0 + ai * HALF + m * 16) * ldc + col0;
#pragma unroll
                for (int bj = 0; bj < 2; ++bj) { const u32x4 w = *(const u32x4*)(hb + off + bj * HALF);
                    const f32x4 h0 = {__builtin_bit_cast(float, w.x << 16), __builtin_bit_cast(float, w.x & 0xffff0000u), __builtin_bit_cast(float, w.y << 16), __builtin_bit_cast(float, w.y & 0xffff0000u)};
                    const f32x4 h1 = {__builtin_bit_cast(float, w.z << 16), __builtin_bit_cast(float, w.z & 0xffff0000u), __builtin_bit_cast(float, w.w << 16), __builtin_bit_cast(float, w.w & 0xffff0000u)};
                    *(f32x4*)(out + off + bj * HALF) = h0 + acc[ai][bj][m][0]; *(f32x4*)(out + off + bj * HALF + 4) = h1 + acc[ai][bj][m][1]; } }
    }
};
struct EpiRes {
    static constexpr bool PERM = false, AFTER_DRAIN = false;
    const float* base; float* out; int ldc;
    __device__ __forceinline__ void operator()(const f32x4 (&acc)[2][2][4][2], const Unit& u, int wr, int wc, int fr, int fq) const {
        const int row0 = u.pm * BM + wr * 64 + fr, col0 = u.pn * BM + wc * 32 + 4 * fq;
#pragma unroll
        for (int ai = 0; ai < 2; ++ai)
#pragma unroll
            for (int m = 0; m < 4; ++m) { const size_t off = (size_t)(row0 + ai * HALF + m * 16) * ldc + col0;
#pragma unroll
                for (int bj = 0; bj < 2; ++bj)
#pragma unroll
                    for (int n = 0; n < 2; ++n) { const f32x4 b = *(const f32x4*)(base + off + bj * HALF + n * 16); *(f32x4*)(out + off + bj * HALF + n * 16) = b + acc[ai][bj][m][n]; } }
    }
};
template <class Epi, class Sched, bool ALIGN_EPI = false, bool SP2 = false>
__device__ __forceinline__ void gemm_phase(PG8_LAS unsigned char* lds, const Gemm g, const Sched& S, const Epi& E) {
    const int tid = threadIdx.x, wid = __builtin_amdgcn_readfirstlane(tid >> 6), lane = tid & 63, wr = wid >> 2, wc = wid & 3, fr = lane & 15, fq = lane >> 4;
    const int K = g.K, nt = K / BK;
    unsigned voffA[2], voffB[2];
#pragma unroll
    for (int i = 0; i < 2; ++i) { int R, C; stage_rc(tid * 16 + i * 8192, R, C); const int Rb = Epi::PERM ? ((R & ~31) + perm32(R & 31)) : R;
        voffA[i] = (unsigned)(R * K + C) * 2u; voffB[i] = (unsigned)(Rb * K + C) * 2u; }
    const size_t kstep = (size_t)(BK * 2);
    const size_t hstep = (size_t)HALF * K * 2;
    const size_t tstep = 2 * hstep;
    const unsigned ldsw = (unsigned)wid * 1024u;
    const int aoff = lds_byte(wr * 64 + fr, fq * 8), boff = lds_byte(wc * 32 + fr, fq * 8);
#define PG8_SA(b, h) (((b) * 2 + (h)) * HTB)
#define PG8_SB(b, h) ((4 + (b) * 2 + (h)) * HTB)
#define PG8_STAGE(bufoff, gbase, voff) do { _Pragma("unroll") for (int _i = 0; _i < 2; ++_i) \
        __builtin_amdgcn_global_load_lds((const unsigned*)((const char*)(gbase) + (voff)[_i]), (PG8_LAS unsigned*)(lds + (bufoff) + ldsw + _i * 8192), 16, 0, 0); } while (0)
#define PG8_LDA(dst, b, h) do { _Pragma("unroll") for (int m = 0; m < 4; ++m) _Pragma("unroll") for (int k = 0; k < 2; ++k) dst[m][k] = *(const PG8_LAS bf16x8*)(lds + PG8_SA(b, h) + aoff + m * 2048 + k * 1024); } while (0)
#define PG8_LDB(dst, b, h) do { _Pragma("unroll") for (int n = 0; n < 2; ++n) _Pragma("unroll") for (int k = 0; k < 2; ++k) dst[n][k] = *(const PG8_LAS bf16x8*)(lds + PG8_SB(b, h) + boff + n * 2048 + k * 1024); } while (0)
#define PG8_MMA(ai, bj, At, Bt) do { __builtin_amdgcn_s_setprio(1); _Pragma("unroll") for (int m = 0; m < 4; ++m) _Pragma("unroll") for (int n = 0; n < 2; ++n) _Pragma("unroll") for (int k = 0; k < 2; ++k) \
        acc[ai][bj][m][n] = __builtin_amdgcn_mfma_f32_16x16x32_bf16(Bt[n][k], At[m][k], acc[ai][bj][m][n], 0, 0, 0); __builtin_amdgcn_s_setprio(0); } while (0)
#define PG8_WAIT_V(n) asm volatile("s_waitcnt vmcnt(" #n ")" ::: "memory")
#define PG8_WAIT_L(n) asm volatile("s_waitcnt lgkmcnt(" #n ")" ::: "memory")
#define PG8_BAR __builtin_amdgcn_s_barrier()
#define PG8_SCHED __builtin_amdgcn_sched_barrier(0)
    Unit cur, nxt; int ui = 0;
    if (!S.next(0, cur)) return;
    f32x4 acc[2][2][4][2];
#pragma unroll
    for (int a = 0; a < 2; ++a)
#pragma unroll
        for (int b = 0; b < 2; ++b)
#pragma unroll
            for (int m = 0; m < 4; ++m)
#pragma unroll
                for (int n = 0; n < 2; ++n) acc[a][b][m][n] = (f32x4){0.f, 0.f, 0.f, 0.f};
    bf16x8 At[4][2], B0[2][2], B1[2][2];
    const char* cA = (const char*)g.A + (size_t)cur.pm * tstep; const char* cB = (const char*)g.Bt + (size_t)cur.pn * tstep;
    S.a_ready(cur);
    if constexpr (SP2) {
        PG8_STAGE(PG8_SB(0, 0), cB, voffB); PG8_STAGE(PG8_SB(0, 1), cB + hstep, voffB); PG8_STAGE(PG8_SA(0, 0), cA, voffA); PG8_STAGE(PG8_SA(0, 1), cA + hstep, voffA);
        if (wr == 1) PG8_BAR;
        PG8_WAIT_V(2); PG8_BAR;
        PG8_STAGE(PG8_SB(1, 0), cB + kstep, voffB); PG8_STAGE(PG8_SA(1, 0), cA + kstep, voffA); PG8_STAGE(PG8_SB(1, 1), cB + hstep + kstep, voffB);
        PG8_WAIT_V(6); PG8_BAR;
    } else {
        PG8_STAGE(PG8_SB(0, 0), cB, voffB); PG8_STAGE(PG8_SA(0, 0), cA, voffA); PG8_STAGE(PG8_SB(0, 1), cB + hstep, voffB); PG8_STAGE(PG8_SA(0, 1), cA + hstep, voffA);
        if (wr == 1) PG8_BAR;
        PG8_WAIT_V(4); PG8_BAR;
        PG8_STAGE(PG8_SB(1, 0), cB + kstep, voffB); PG8_STAGE(PG8_SA(1, 0), cA + kstep, voffA); PG8_STAGE(PG8_SB(1, 1), cB + hstep + kstep, voffB);
        PG8_WAIT_V(6); PG8_BAR;
    }
    for (;;) {
        const bool has_next = S.next(ui + 1, nxt);
        const char* nA = has_next ? (const char*)g.A + (size_t)nxt.pm * tstep : cA; const char* nB = has_next ? (const char*)g.Bt + (size_t)nxt.pn * tstep : cB;
        for (int t = 0; t < nt; t += 2) {
            const bool last = (t == nt - 2);
            const char* a1 = cA + (size_t)(t + 1) * kstep;
            const char* a2 = last ? nA : cA + (size_t)(t + 2) * kstep; const char* b2 = last ? nB : cB + (size_t)(t + 2) * kstep;
            const char* a3 = a2 + kstep; const char* b3 = b2 + kstep;
            if (last && has_next) S.a_ready(nxt);
            if constexpr (SP2) {
            PG8_LDB(B0, 0, 0); PG8_LDB(B1, 0, 1); PG8_SCHED; PG8_LDA(At, 0, 0); PG8_STAGE(PG8_SA(1, 1), a1 + hstep, voffA);
            PG8_WAIT_V(8); PG8_WAIT_L(0); PG8_BAR; PG8_MMA(0, 0, At, B0); PG8_MMA(0, 1, At, B1); PG8_BAR; PG8_SCHED;
            PG8_LDA(At, 0, 1); PG8_STAGE(PG8_SB(0, 0), b2, voffB); PG8_STAGE(PG8_SB(0, 1), b2 + hstep, voffB); PG8_STAGE(PG8_SA(0, 0), a2, voffA);
            PG8_WAIT_V(8); PG8_WAIT_L(0); PG8_BAR; PG8_MMA(1, 0, At, B0); PG8_MMA(1, 1, At, B1); PG8_BAR; PG8_SCHED;
            PG8_LDB(B0, 1, 0); PG8_LDB(B1, 1, 1); PG8_SCHED; PG8_LDA(At, 1, 0); PG8_STAGE(PG8_SA(0, 1), a2 + hstep, voffA);
            PG8_WAIT_V(8); PG8_WAIT_L(0); PG8_BAR; PG8_MMA(0, 0, At, B0); PG8_MMA(0, 1, At, B1); PG8_BAR; PG8_SCHED;
            PG8_LDA(At, 1, 1); PG8_STAGE(PG8_SB(1, 0), b3, voffB); PG8_STAGE(PG8_SB(1, 1), b3 + hstep, voffB); PG8_STAGE(PG8_SA(1, 0), a3, voffA);
            PG8_WAIT_V(8); PG8_WAIT_L(0); PG8_BAR; PG8_MMA(1, 0, At, B0); PG8_MMA(1, 1, At, B1); PG8_BAR; PG8_SCHED;
            } else {
            PG8_LDB(B0, 0, 0); PG8_SCHED; PG8_LDA(At, 0, 0); PG8_STAGE(PG8_SA(1, 1), a1 + hstep, voffA);
            PG8_WAIT_L(8); PG8_BAR; PG8_WAIT_L(0); PG8_MMA(0, 0, At, B0); PG8_BAR; PG8_SCHED;
            PG8_LDB(B1, 0, 1); PG8_STAGE(PG8_SB(0, 0), b2, voffB);
            PG8_BAR; PG8_WAIT_L(0); PG8_MMA(0, 1, At, B1); PG8_BAR;
            PG8_LDA(At, 0, 1); PG8_STAGE(PG8_SA(0, 0), a2, voffA);
            PG8_BAR; PG8_WAIT_L(0); PG8_MMA(1, 0, At, B0); PG8_BAR; PG8_SCHED;
            PG8_STAGE(PG8_SB(0, 1), b2 + hstep, voffB);
            PG8_WAIT_V(6); PG8_BAR; PG8_MMA(1, 1, At, B1); PG8_BAR;
            PG8_LDB(B0, 1, 0); PG8_SCHED; PG8_LDA(At, 1, 0); PG8_STAGE(PG8_SA(0, 1), a2 + hstep, voffA);
            PG8_WAIT_L(8); PG8_BAR; PG8_WAIT_L(0); PG8_MMA(0, 0, At, B0); PG8_BAR; PG8_SCHED;
            PG8_LDB(B1, 1, 1); PG8_STAGE(PG8_SB(1, 0), b3, voffB);
            PG8_BAR; PG8_WAIT_L(0); PG8_MMA(0, 1, At, B1); PG8_BAR;
            PG8_LDA(At, 1, 1); PG8_STAGE(PG8_SA(1, 0), a3, voffA);
            PG8_BAR; PG8_WAIT_L(0); PG8_MMA(1, 0, At, B0); PG8_BAR; PG8_SCHED;
            PG8_STAGE(PG8_SB(1, 1), b3 + hstep, voffB);
            PG8_WAIT_V(6); PG8_BAR; PG8_MMA(1, 1, At, B1); PG8_BAR;
            }
        }
        if constexpr (ALIGN_EPI) { if (wr == 0) PG8_BAR; }
        if constexpr (!Epi::AFTER_DRAIN) { E(acc, cur, wr, wc, fr, fq); S.done(cur); }
        if (!has_next) break;
#pragma unroll
        for (int a = 0; a < 2; ++a)
#pragma unroll
            for (int b = 0; b < 2; ++b)
#pragma unroll
                for (int m = 0; m < 4; ++m)
#pragma unroll
                    for (int n = 0; n < 2; ++n) acc[a][b][m][n] = (f32x4){0.f, 0.f, 0.f, 0.f};
        cur = nxt; cA = nA; cB = nB; ++ui;
        if constexpr (ALIGN_EPI) { if (wr == 1) PG8_BAR; }
    }
    PG8_WAIT_V(0);
    if constexpr (!ALIGN_EPI) { if (wr == 0) PG8_BAR; }
    PG8_BAR;
    if constexpr (Epi::AFTER_DRAIN) { E.fused(acc, cur, wr, wc, fr, fq, lds, wid, lane); S.done(cur); }
#undef PG8_SA
#undef PG8_SB
#undef PG8_STAGE
#undef PG8_LDA
#undef PG8_LDB
#undef PG8_MMA
#undef PG8_WAIT_V
#undef PG8_WAIT_L
#undef PG8_BAR
#undef PG8_SCHED
}
}
constexpr int BATCH = 4, SEQ = 8192, DM = 2048, M_TOK = BATCH * SEQ;
constexpr int NHEAD = 4, HD = 128, VD = 256, ATT_W = 1024, CONV_CH = 1024, CONV_W = 31, IN_COLS = 5120, FFN = 5632;
constexpr float EPS_RMS = 1e-6f, EPS_LN = 1e-5f, LAMBDA_INIT = 0.2f;
constexpr float QSCALE = 0.08838834764831845f * 1.4426950408889634f;
constexpr int NTHREADS = 512, NWAVES = 8;

constexpr size_t MiB = 1u << 20;
constexpr size_t WS_COS = 1 * MiB, WS_SIN = 3 * MiB, WS_RSS = 5 * MiB, WS_RS = 6 * MiB, WS_RS1 = 7 * MiB;
constexpr size_t WS_WIN = 8 * MiB;
constexpr size_t WS_WV = 24 * MiB;
constexpr size_t WS_WOUT = 28 * MiB;
constexpr size_t WS_WGU = 36 * MiB;
constexpr size_t WS_WDN = 80 * MiB;
constexpr size_t WS_XN = 104 * MiB;
constexpr size_t WS_Q = 232 * MiB, WS_K = 296 * MiB, WS_VT = 360 * MiB, WS_U = 424 * MiB, WS_MIX = 488 * MiB;
constexpr size_t WS_ACT = 232 * MiB;
constexpr size_t WS_END = 616 * MiB;

#define LAS __attribute__((address_space(3)))
typedef unsigned short bf16;
typedef unsigned v4u __attribute__((ext_vector_type(4)));
typedef unsigned v2u __attribute__((ext_vector_type(2)));
typedef float f32x4 __attribute__((ext_vector_type(4)));
typedef float f32x2 __attribute__((ext_vector_type(2)));
typedef short bf16x8 __attribute__((ext_vector_type(8)));
typedef float f32x16 __attribute__((ext_vector_type(16)));
constexpr int LDS_BYTES = 131072 + 4096 + 64;
constexpr int MISC_OFF = 131072, BARST_OFF = 131072 + 4096;
constexpr size_t WS_BAR = 0, BAR_ZERO_BYTES = 16384;

__device__ __forceinline__ unsigned f2bf(float f) { unsigned u = __builtin_bit_cast(unsigned, f); return (u + 0x7fffu + ((u >> 16) & 1u)) >> 16; }
__device__ __forceinline__ unsigned pk2(float lo, float hi) { return pg8::cvt_pk_bf16(lo, hi); }
__device__ __forceinline__ float bflo(unsigned w) { return __builtin_bit_cast(float, w << 16); }
__device__ __forceinline__ float bfhi(unsigned w) { return __builtin_bit_cast(float, w & 0xffff0000u); }
__device__ __forceinline__ float wave_sum(float v) {
#pragma unroll
    for (int o = 1; o < 64; o <<= 1) v += __shfl_xor(v, o);
    return v;
}
__device__ __forceinline__ float wave_max(float v) {
#pragma unroll
    for (int o = 1; o < 64; o <<= 1) v = fmaxf(v, __shfl_xor(v, o));
    return v;
}
#define LDS_WAIT() asm volatile("s_waitcnt lgkmcnt(0)" ::: "memory")

__device__ __forceinline__ void transpose_item(const float* W, int K, int N, int k0, int n0, bf16* dst, const float* kscale, LAS unsigned char* scr, int lane) {
    const int r = lane >> 4, c = lane & 15;
    f32x4 v[16];
#pragma unroll
    for (int j = 0; j < 8; ++j)
#pragma unroll
        for (int p = 0; p < 2; ++p) v[2 * j + p] = *(const f32x4*)(W + (size_t)(k0 + 8 * j + 2 * r + p) * N + n0 + 4 * c);
#pragma unroll
    for (int j = 0; j < 8; ++j) { const int k = 8 * j + 2 * r; float s0 = 1.0f, s1 = 1.0f; if (kscale) { const f32x2 sc = *(const f32x2*)(kscale + k0 + k); s0 = sc.x; s1 = sc.y; }
#pragma unroll
        for (int i = 0; i < 4; ++i) { const int n = 4 * c + i; *(LAS unsigned*)(scr + n * 128 + ((j ^ (c & 7)) << 4) + 4 * r) = pk2(v[2 * j][i] * s0, v[2 * j + 1][i] * s1); } }
    LDS_WAIT(); asm volatile("" ::: "memory");
    const int rr = lane >> 3, cc = lane & 7;
#pragma unroll
    for (int j = 0; j < 8; ++j) { const int n = 8 * j + rr; const v4u o = *(const LAS v4u*)(scr + n * 128 + ((cc ^ ((n >> 2) & 7)) << 4)); *(v4u*)(dst + (size_t)n * K + k0 + 8 * cc) = o; }
    LDS_WAIT(); asm volatile("" ::: "memory");
}
__device__ __forceinline__ void rms_load_gain(const float* g, f32x4 (&gg)[8], int lane) {
#pragma unroll
    for (int j = 0; j < 8; ++j) gg[j] = *(const f32x4*)(g + 256 * j + 8 * (lane & 31) + 4 * (lane >> 5));
}
__device__ __forceinline__ void rms_row_to_bf16(const float* xrow, const f32x4 (&gg)[8], bf16* orow, int lane) {
    const int lo = lane & 31, hi = lane >> 5;
    const f32x4* xr = (const f32x4*)xrow + 2 * lo + hi;
    f32x4 v[8]; float s = 0.f;
#pragma unroll
    for (int j = 0; j < 8; ++j) { v[j] = xr[64 * j]; s += (v[j].x * v[j].x + v[j].y * v[j].y) + (v[j].z * v[j].z + v[j].w * v[j].w); }
    const float rinv = 1.0f / sqrtf(wave_sum(s) * (1.f / DM) + EPS_RMS);
#pragma unroll
    for (int i = 0; i < 4; ++i) { v2u wa, wb;
        { const f32x4 x = v[2 * i], g = gg[2 * i]; wa.x = pk2(x.x * rinv * g.x, x.y * rinv * g.y); wa.y = pk2(x.z * rinv * g.z, x.w * rinv * g.w); }
        { const f32x4 x = v[2 * i + 1], g = gg[2 * i + 1]; wb.x = pk2(x.x * rinv * g.x, x.y * rinv * g.y); wb.y = pk2(x.z * rinv * g.z, x.w * rinv * g.w); }
        const auto rx = __builtin_amdgcn_permlane32_swap(wa.x, wb.x, false, false);
        const auto ry = __builtin_amdgcn_permlane32_swap(wa.y, wb.y, false, false);
        v4u w16; w16.x = rx[0]; w16.y = ry[0]; w16.z = rx[1]; w16.w = ry[1];
        *(v4u*)(orow + 256 * (2 * i + hi) + 8 * lo) = w16; }
}

__device__ __forceinline__ void x_row_to_bf16(const float* xrow, bf16* orow, float* rs, int lane) {
    const int lo = lane & 31, hi = lane >> 5;
    const f32x4* xr = (const f32x4*)xrow + 2 * lo + hi;
    f32x4 v[8]; float s = 0.f;
#pragma unroll
    for (int j = 0; j < 8; ++j) { v[j] = xr[64 * j]; s += (v[j].x * v[j].x + v[j].y * v[j].y) + (v[j].z * v[j].z + v[j].w * v[j].w); }
    const float rinv = 1.0f / sqrtf(wave_sum(s) * (1.f / DM) + EPS_RMS);
    if (lane == 0) *rs = rinv;
#pragma unroll
    for (int i = 0; i < 4; ++i) { v2u wa, wb;
        { const f32x4 x = v[2 * i]; wa.x = pk2(x.x, x.y); wa.y = pk2(x.z, x.w); }
        { const f32x4 x = v[2 * i + 1]; wb.x = pk2(x.x, x.y); wb.y = pk2(x.z, x.w); }
        const auto rx = __builtin_amdgcn_permlane32_swap(wa.x, wb.x, false, false);
        const auto ry = __builtin_amdgcn_permlane32_swap(wa.y, wb.y, false, false);
        v4u w16; w16.x = rx[0]; w16.y = ry[0]; w16.z = rx[1]; w16.w = ry[1];
        *(v4u*)(orow + 256 * (2 * i + hi) + 8 * lo) = w16; }
}

struct Ptrs {
    const float *x, *norm1_g, *w_in, *q_norm_g, *k_norm_g, *lq1, *lk1, *lq2, *lk2, *subln_g, *conv_w, *conv_b, *conv_ln_g, *conv_ln_b, *w_out, *norm2_g, *w_gate, *w_up, *w_down;
    float* out;
    bf16 *Wt_in, *Wt_v, *Wt_out, *Wt_gu, *Wt_dn, *XN, *Q, *K, *VT, *U, *MIX, *ACT;
    float *COS, *SIN, *RSS, *RS, *RS1;
};

__device__ __forceinline__ void p0_prologue(const Ptrs& P, LAS unsigned char* lds, int gw, int NGW, int wave, int lane) {
    LAS unsigned char* scr = lds + wave * 16384;
    constexpr int I_IN = 32 * 80, I_OUT = 32 * 32, I_G = 32 * 88, I_D = 88 * 32;
    constexpr int NITEMS = I_IN + I_OUT + 2 * I_G + I_D;
    for (int it = gw; it < NITEMS; it += NGW) {
        int r = it;
        if (r < I_IN) { const int kb = r / 80, n0 = (r % 80) * 64; bf16* dst;
            if (n0 < 2048) dst = P.Wt_in + (size_t)n0 * DM;
            else if (n0 < 3072) dst = P.Wt_v + (size_t)(n0 - 2048) * DM;
            else if (n0 < 4096) { const int ch = n0 - 3072; dst = P.Wt_in + (size_t)(2048 + (ch >> 7) * 256 + (ch & 127)) * DM; }
            else { const int ch = n0 - 4096; dst = P.Wt_in + (size_t)(2048 + (ch >> 7) * 256 + 128 + (ch & 127)) * DM; }
            transpose_item(P.w_in, DM, IN_COLS, kb * 64, n0, dst, P.norm1_g, scr, lane); continue; }
        r -= I_IN;
        if (r < I_OUT) { const int kb = r / 32, n0 = (r % 32) * 64; transpose_item(P.w_out, DM, DM, kb * 64, n0, P.Wt_out + (size_t)n0 * DM, nullptr, scr, lane); continue; }
        r -= I_OUT;
        if (r < I_G) { const int kb = r / 88, n0 = (r % 88) * 64; transpose_item(P.w_gate, DM, FFN, kb * 64, n0, P.Wt_gu + (size_t)((n0 >> 7) * 256 + (n0 & 127)) * DM, P.norm2_g, scr, lane); continue; }
        r -= I_G;
        if (r < I_G) { const int kb = r / 88, n0 = (r % 88) * 64; transpose_item(P.w_up, DM, FFN, kb * 64, n0, P.Wt_gu + (size_t)((n0 >> 7) * 256 + 128 + (n0 & 127)) * DM, P.norm2_g, scr, lane); continue; }
        r -= I_G;
        { const int kb = r / 32, n0 = (r % 32) * 64; transpose_item(P.w_down, FFN, DM, kb * 64, n0, P.Wt_dn + (size_t)n0 * FFN, nullptr, scr, lane); }
    }
    for (int m = gw; m < M_TOK; m += NGW) x_row_to_bf16(P.x + (size_t)m * DM, P.XN + (size_t)m * DM, P.RS1 + m, lane);
    for (int i = gw * 64 + lane; i < SEQ * 64; i += NGW * 64) {
        const int pos = i >> 6, j = i & 63;
        const float inv = (float)exp2(-(double)j * (13.287712379549449 / 64.0));
        const float ang = (float)pos * inv;
        double rev = (double)ang * 0.15915494309189535; rev -= rint(rev);
        const float fr = (float)rev;
        P.COS[i] = __builtin_amdgcn_cosf(fr); P.SIN[i] = __builtin_amdgcn_sinf(fr);
    }
}

__device__ __forceinline__ void p2_qk_norm_rope(const Ptrs& P, int gw, int NGW, int lane) {
    const int sub = lane & 7, grp = lane >> 3;
    f32x4 gq[4], gk[4];
#pragma unroll
    for (int i = 0; i < 4; ++i) { const int o = sub * 8 + (i & 1) * 4 + (i >> 1) * 64; gq[i] = *(const f32x4*)(P.q_norm_g + o); gk[i] = *(const f32x4*)(P.k_norm_g + o); }
    for (int row = gw; row < M_TOK; row += NGW) {
        bf16* pq = P.Q + (size_t)row * 1024 + grp * 128 + sub * 8; bf16* pk = P.K + (size_t)row * 1024 + grp * 128 + sub * 8;
        const v4u q1 = *(const v4u*)pq, q2 = *(const v4u*)(pq + 64), k1 = *(const v4u*)pk, k2 = *(const v4u*)(pk + 64);
        const int pos = row & (SEQ - 1);
        const f32x4 c0 = *(const f32x4*)(P.COS + pos * 64 + sub * 8), c1 = *(const f32x4*)(P.COS + pos * 64 + sub * 8 + 4);
        const f32x4 s0 = *(const f32x4*)(P.SIN + pos * 64 + sub * 8), s1 = *(const f32x4*)(P.SIN + pos * 64 + sub * 8 + 4);
#pragma unroll
        for (int which = 0; which < 2; ++which) {
            const v4u r1 = which ? k1 : q1, r2 = which ? k2 : q2;
            float t1[8], t2[8];
#pragma unroll
            for (int j = 0; j < 4; ++j) { t1[2 * j] = bflo(r1[j]); t1[2 * j + 1] = bfhi(r1[j]); t2[2 * j] = bflo(r2[j]); t2[2 * j + 1] = bfhi(r2[j]); }
            float ss = 0.f;
#pragma unroll
            for (int j = 0; j < 8; ++j) ss += t1[j] * t1[j] + t2[j] * t2[j];
            ss += __shfl_xor(ss, 1); ss += __shfl_xor(ss, 2); ss += __shfl_xor(ss, 4);
            const float rinv = (1.0f / sqrtf(ss * (1.f / HD) + EPS_RMS)) * (which ? 1.0f : QSCALE);
            float o1[8], o2[8];
#pragma unroll
            for (int j = 0; j < 8; ++j) {
                const float cc = j < 4 ? c0[j & 3] : c1[j & 3], sn = j < 4 ? s0[j & 3] : s1[j & 3];
                const float ga = which ? (j < 4 ? gk[0][j & 3] : gk[1][j & 3]) : (j < 4 ? gq[0][j & 3] : gq[1][j & 3]);
                const float gb = which ? (j < 4 ? gk[2][j & 3] : gk[3][j & 3]) : (j < 4 ? gq[2][j & 3] : gq[3][j & 3]);
                const float n1 = t1[j] * rinv * ga, n2 = t2[j] * rinv * gb;
                o1[j] = n1 * cc - n2 * sn; o2[j] = n2 * cc + n1 * sn;
            }
            v4u w1, w2;
#pragma unroll
            for (int j = 0; j < 4; ++j) { w1[j] = pk2(o1[2 * j], o1[2 * j + 1]); w2[j] = pk2(o2[2 * j], o2[2 * j + 1]); }
            bf16* p = which ? pk : pq;
            *(v4u*)p = w1; *(v4u*)(p + 64) = w2;
        }
    }
}

__device__ __forceinline__ void glds16c(const void* sbase, unsigned voff, unsigned lds_dst) {
    unsigned keep;
    asm volatile("s_mov_b32 %0, m0\n\ts_mov_b32 m0, %3\n\ts_nop 0\n\tglobal_load_lds_dwordx4 %1, %2\n\ts_mov_b32 m0, %0" : "=&s"(keep) : "v"(voff), "s"(sbase), "s"(lds_dst) : "memory");
}
#define CBAR() do { LDS_WAIT(); asm volatile("" ::: "memory"); __builtin_amdgcn_s_barrier(); asm volatile("" ::: "memory"); } while (0)
#define CONV_ISSUE(item_) do { const int row0_ = (item_) * 16, s0_ = row0_ & (SEQ - 1); \
        _Pragma("nounroll") for (int k_ = 0; k_ < 12; ++k_) { const int p_ = wave + 8 * k_; if (p_ < 92) { const int r_ = p_ >> 1; const int rr_ = (s0_ - 30 + r_ < 0) ? 30 : r_; \
            glds16c((const char*)P.U + ((size_t)(row0_ - 30 + rr_) * 2048 + (size_t)(p_ & 1) * 1024), (unsigned)lane * 16u, lds0 + (unsigned)p_ * 1024u); } } } while (0)
__device__ __forceinline__ void p3_conv(const Ptrs& P, LAS unsigned char* lds, int first, int stride, int tid, int wave, int lane) {
    const int ch = 2 * tid;
    constexpr int NITEMS = M_TOK / 16, OT_OFF = 94208;
    f32x2 w[CONV_W];
#pragma unroll
    for (int k = 0; k < CONV_W; ++k) w[k] = *(const f32x2*)(P.conv_w + k * CONV_CH + ch);
    const f32x2 cb = *(const f32x2*)(P.conv_b + ch), lg = *(const f32x2*)(P.conv_ln_g + ch), lb = *(const f32x2*)(P.conv_ln_b + ch);
    LAS float* red = (LAS float*)(lds + MISC_OFF);
    LAS float* stat = red + 256;
    int bpi[6];
#pragma unroll
    for (int k = 0; k < 6; ++k) bpi[k] = (lane ^ (1 << k)) << 2;
    const unsigned lds0 = (unsigned)__builtin_amdgcn_readfirstlane((int)(unsigned)(uintptr_t)lds);
    asm volatile("s_waitcnt vmcnt(0)" ::: "memory");
#pragma unroll
    for (int k = 0; k < CONV_W; ++k) asm volatile("" : "+v"(w[k]));
    if (first < NITEMS) CONV_ISSUE(first);
    for (int item = first; item < NITEMS; item += stride) {
        const int row0 = item * 16, s0 = row0 & (SEQ - 1);
        asm volatile("s_waitcnt vmcnt(0)" ::: "memory");
        CBAR();
        unsigned uv[46];
#pragma unroll
        for (int r = 0; r < 46; ++r) { const int neg = (s0 - 30 + r) >> 31;
            uv[r] = *(const LAS unsigned*)(lds + r * 2048 + tid * 4) & ~(unsigned)neg; }
        CBAR();
        if (item + stride < NITEMS) CONV_ISSUE(item + stride);
        f32x2 a[16];
#pragma unroll
        for (int t = 0; t < 16; ++t) a[t] = cb;
#pragma unroll
        for (int r = 0; r < 46; ++r) {
            const f32x2 u = (f32x2){bflo(uv[r]), bfhi(uv[r])};
#pragma unroll
            for (int t = 0; t < 16; ++t) { const int k = r - t; if (k >= 0 && k < CONV_W) a[t] += u * w[k]; }
        }
#pragma unroll
        for (int t = 0; t < 16; ++t) {
            float s1 = a[t].x + a[t].y, s2 = a[t].x * a[t].x + a[t].y * a[t].y;
#pragma unroll
            for (int k = 0; k < 6; ++k) {
                s1 += __builtin_bit_cast(float, __builtin_amdgcn_ds_bpermute(bpi[k], __builtin_bit_cast(int, s1)));
                s2 += __builtin_bit_cast(float, __builtin_amdgcn_ds_bpermute(bpi[k], __builtin_bit_cast(int, s2)));
            }
            if (lane == 0) { red[(wave * 16 + t) * 2] = s1; red[(wave * 16 + t) * 2 + 1] = s2; }
        }
        CBAR();
        if (tid < 16) { float s1 = 0.f, s2 = 0.f;
#pragma unroll
            for (int ww = 0; ww < 8; ++ww) { s1 += red[(ww * 16 + tid) * 2]; s2 += red[(ww * 16 + tid) * 2 + 1]; }
            const float mu = s1 * (1.f / CONV_CH), var = fmaxf(s2 * (1.f / CONV_CH) - mu * mu, 0.f);
            stat[tid * 2] = mu; stat[tid * 2 + 1] = 1.0f / sqrtf(var + EPS_LN); }
        CBAR();
#pragma unroll
        for (int t = 0; t < 16; ++t) {
            const float mu = stat[t * 2], rs = stat[t * 2 + 1];
            const float y0 = (a[t].x - mu) * rs * lg.x + lb.x, y1 = (a[t].y - mu) * rs * lg.y + lb.y;
            *(LAS unsigned*)(lds + OT_OFF + t * 2048 + tid * 4) = pk2(y0 * pg8::sigmoid_fast(y0), y1 * pg8::sigmoid_fast(y1));
        }
        CBAR();
#pragma unroll
        for (int k = 0; k < 4; ++k) { const int c = tid + 512 * k; const v4u v = *(const LAS v4u*)(lds + OT_OFF + c * 16);
            *(v4u*)((char*)P.MIX + ((size_t)(row0 + (c >> 7)) * DM + ATT_W) * 2 + (size_t)(c & 127) * 16) = v; }
        CBAR();
    }
    asm volatile("s_waitcnt vmcnt(0)" ::: "memory");
}
#undef CONV_ISSUE
#undef CBAR

namespace att {
constexpr int BUF = 65536, V_OFF = 32768;
__device__ __forceinline__ void glds16(const void* sbase, unsigned voff, unsigned lds_dst) {
    unsigned keep;
    asm volatile("s_mov_b32 %0, m0\n\ts_mov_b32 m0, %3\n\ts_nop 0\n\tglobal_load_lds_dwordx4 %1, %2\n\ts_mov_b32 m0, %0" : "=&s"(keep) : "v"(voff), "s"(sbase), "s"(lds_dst) : "memory");
}
__device__ __forceinline__ int pi32(int i) { return (i & ~12) | ((i & 4) << 1) | ((i & 8) >> 1); }
#define ATT_WAIT_V(n) asm volatile("s_waitcnt vmcnt(" #n ")" ::: "memory")
#define ATT_BAR() do { asm volatile("" ::: "memory"); __builtin_amdgcn_s_barrier(); asm volatile("" ::: "memory"); } while (0)

__device__ __forceinline__ void attn_block(LAS unsigned char* lds, const Ptrs& P, int b, int h, int qb, float negMb, float lam, int tid, int wid, int lane) {
    const int comp = wid & 1, quarter = wid >> 1, l31 = lane & 31, hh = lane >> 5;
    const int NT = 2 * qb + 2;
    const size_t tok0 = (size_t)b * SEQ;
    const int qpos = qb * 128 + quarter * 32 + l31;
    bf16x8 qf[8];
    { const bf16* qp = P.Q + (tok0 + qpos) * 1024 + h * 256 + comp * 128 + hh * 8;
#pragma unroll
      for (int ks = 0; ks < 8; ++ks) qf[ks] = *(const bf16x8*)(qp + ks * 16); }
    const unsigned ldsw = (unsigned)wid * 4096u;
    const unsigned lds0 = (unsigned)__builtin_amdgcn_readfirstlane((int)(unsigned)(uintptr_t)lds);
    unsigned kb0, kx16, vb0, vy16;
    { int ln_ = lane; asm volatile("" : "+v"(ln_));
      kb0 = (unsigned)(((16 * (wid & 3) + (ln_ >> 4)) * 1024 + h * 256 + (wid >> 2) * 128) * 2); kx16 = (unsigned)(((ln_ & 15) ^ (ln_ >> 4)) << 4);
      vb0 = (unsigned)(((h * 256 + 32 * wid + (ln_ >> 3)) * M_TOK) * 2); vy16 = (unsigned)(((ln_ & 7) ^ (ln_ >> 4)) << 4);
      asm volatile("" : "+v"(kb0), "+v"(kx16), "+v"(vb0), "+v"(vy16)); }
#define ATT_DMA(t, bufi) do { const char* kb_ = (const char*)P.K + (tok0 + (size_t)(t) * 64) * 2048; const char* vb_ = (const char*)P.VT + (tok0 + (size_t)(t) * 64) * 2; \
        _Pragma("unroll") for (int pp = 0; pp < 4; ++pp) glds16(kb_, kb0 + pp * 8192 + (kx16 ^ (64 * pp)), lds0 + (bufi) * BUF + ldsw + pp * 1024); \
        _Pragma("unroll") for (int pp = 0; pp < 4; ++pp) glds16(vb_, vb0 + pp * (8 * M_TOK * 2) + (vy16 ^ (64 * (pp & 1))), lds0 + (bufi) * BUF + V_OFF + ldsw + pp * 1024); } while (0)
    f32x16 o[8];
#pragma unroll
    for (int e = 0; e < 8; ++e)
#pragma unroll
        for (int r = 0; r < 16; ++r) o[e][r] = 0.f;
    float lsum = 0.f;
    ATT_WAIT_V(0);
#pragma unroll
    for (int ks = 0; ks < 8; ++ks) asm volatile("" : "+v"(qf[ks]));
    ATT_DMA(0, 0);
    const bool early = wid < 4;
    for (int t = 0; t < NT; ++t) {
        ATT_WAIT_V(0);
        LDS_WAIT();
        ATT_BAR();
        const bool more = t + 1 < NT;
        if (more && early) ATT_DMA(t + 1, (t + 1) & 1);
        const bool active = (quarter >= 2) || more;
        const LAS unsigned char* base = lds + (t & 1) * BUF;
        int ln2 = lane; asm volatile("" : "+v"(ln2));
        const int l31b = ln2 & 31, hhb = ln2 >> 5;
        const int krow = pi32(l31b), kx = krow & 15;
        const int koffr = comp * 16384 + krow * 256;
        const int vx = (l31b >> 1) & 7;
        const int voffr = V_OFF + l31b * 128;
#pragma unroll
        for (int T = 0; T < 2; ++T) {
            if (T == 1 && more && !early) ATT_DMA(t + 1, (t + 1) & 1);
            if (active) {
                f32x16 s;
#pragma unroll
                for (int r = 0; r < 16; ++r) s[r] = negMb;
#pragma unroll
                for (int ks = 0; ks < 8; ++ks) {
                    const bf16x8 kf = *(const LAS bf16x8*)(base + koffr + T * 8192 + (((2 * ks + hhb) ^ kx) << 4));
                    s = __builtin_amdgcn_mfma_f32_32x32x16_bf16(kf, qf[ks], s, 0, 0, 0);
                }
                float ps = 0.f;
#pragma unroll
                for (int r = 0; r < 16; ++r) { s[r] = __builtin_amdgcn_exp2f(s[r]); ps += s[r]; }
                lsum += ps;
#pragma unroll
                for (int sI = 0; sI < 2; ++sI) { v4u w;
#pragma unroll
                    for (int j = 0; j < 4; ++j) w[j] = pk2(s[8 * sI + 2 * j], s[8 * sI + 2 * j + 1]);
                    const bf16x8 pf = __builtin_bit_cast(bf16x8, w);
                    const LAS unsigned char* vb = base + voffr + (((2 * (2 * T + sI) + hhb) ^ vx) << 4);
#pragma unroll
                    for (int e = 0; e < 8; ++e) {
                        const bf16x8 vf = *(const LAS bf16x8*)(vb + e * 4096);
                        o[e] = __builtin_amdgcn_mfma_f32_32x32x16_bf16(vf, pf, o[e], 0, 0, 0);
                    }
                }
            }
        }
    }
    LDS_WAIT();
    ATT_BAR();
    const float ltot = lsum + __shfl_xor(lsum, 32);
    const float inv = 1.0f / ltot;
    int ln3 = lane; asm volatile("" : "+v"(ln3));
    const int hh3 = ln3 >> 5, qpos3 = qb * 128 + quarter * 32 + (ln3 & 31);
    LAS unsigned char* xb = lds + quarter * 32768 + ln3 * 16;
    if (comp == 1) {
        const float sc = lam * inv;
#pragma unroll
        for (int e = 0; e < 8; ++e)
#pragma unroll
            for (int r4 = 0; r4 < 4; ++r4) *(LAS f32x4*)(xb + (e * 4 + r4) * 1024) = (f32x4){o[e][4 * r4] * sc, o[e][4 * r4 + 1] * sc, o[e][4 * r4 + 2] * sc, o[e][4 * r4 + 3] * sc};
    }
    LDS_WAIT();
    ATT_BAR();
    if (comp == 0) {
        float ss = 0.f;
#pragma unroll
        for (int e = 0; e < 8; ++e)
#pragma unroll
            for (int r4 = 0; r4 < 4; ++r4) { const f32x4 x1 = *(const LAS f32x4*)(xb + (e * 4 + r4) * 1024);
#pragma unroll
                for (int i = 0; i < 4; ++i) { const float v = o[e][4 * r4 + i] * inv - x1[i]; o[e][4 * r4 + i] = v; ss += v * v; } }
        ss += __shfl_xor(ss, 32);
        const float rn = (1.0f / sqrtf(ss * (1.f / VD) + EPS_RMS)) * (1.0f - LAMBDA_INIT);
        bf16* orow = P.MIX + (tok0 + qpos3) * DM + h * 256 + 8 * hh3;
        const LAS float* gp = (const LAS float*)(lds + MISC_OFF + 3072) + 4 * hh3;
#pragma unroll
        for (int e = 0; e < 8; ++e)
#pragma unroll
            for (int i2 = 0; i2 < 2; ++i2) { v2u wab[2];
#pragma unroll
                for (int q = 0; q < 2; ++q) { const int r4 = 2 * i2 + q; const f32x4 g = *(const LAS f32x4*)(gp + 32 * e + 8 * r4);
                    wab[q].x = pk2(o[e][4 * r4] * rn * g[0], o[e][4 * r4 + 1] * rn * g[1]); wab[q].y = pk2(o[e][4 * r4 + 2] * rn * g[2], o[e][4 * r4 + 3] * rn * g[3]); }
                const auto rx = __builtin_amdgcn_permlane32_swap(wab[0].x, wab[1].x, false, false);
                const auto ry = __builtin_amdgcn_permlane32_swap(wab[0].y, wab[1].y, false, false);
                v4u w16; w16.x = rx[0]; w16.y = ry[0]; w16.z = rx[1]; w16.w = ry[1];
                *(v4u*)(orow + 32 * e + 16 * i2) = w16; }
    }
    LDS_WAIT();
    ATT_BAR();
#undef ATT_DMA
}
}

#define XB_TMO      128
#define XB_XCNT(j)  (256  + 64 * (j))
#define XB_XSUB(j)  (1280 + 64 * (j))
#define XB_XGEN(j)  (2304 + 64 * (j))
#define XB_TOP      3328
#define XB_TOPGEN   3392
#define XCD_BAR_WORDS 3456
#define XB_SPIN_CAP (1u << 18)

__device__ __forceinline__ unsigned xb_ld(unsigned* p)              { return __hip_atomic_load(p, __ATOMIC_RELAXED, __HIP_MEMORY_SCOPE_AGENT); }
__device__ __forceinline__ unsigned xb_add(unsigned* p, unsigned v) { return __hip_atomic_fetch_add(p, v, __ATOMIC_RELAXED, __HIP_MEMORY_SCOPE_AGENT); }
__device__ __forceinline__ unsigned xb_xcc_id() { return (unsigned)__builtin_amdgcn_s_getreg((3 << 11) | 20) & 0xFu; }
#define XB_SPIN(cond, bar) do { unsigned _sp = 0; while (cond) { __builtin_amdgcn_s_sleep(1); \
    if ((++_sp & 255u) == 0u) { if (xb_ld(&(bar)[XB_TMO])) break; if (_sp > XB_SPIN_CAP) { atomicAdd(&(bar)[XB_TMO], 1u); break; } } } } while (0)

struct XcdBarrier {
    unsigned* bar; unsigned x;
    volatile LAS unsigned* st;
};

__device__ __forceinline__ XcdBarrier xcd_barrier_post(unsigned* bar, volatile LAS unsigned* st) {
    XcdBarrier b; b.bar = bar; b.x = xb_xcc_id(); b.st = st;
    if (threadIdx.x == 0) (void)xb_add(&bar[XB_XCNT(b.x)], 1u);
    return b;
}
__device__ __forceinline__ void xcd_barrier_complete(unsigned* bar, unsigned x, unsigned& nloc, unsigned& nx) {
    const unsigned G = gridDim.x * gridDim.y * gridDim.z;
    unsigned sum, cnt, mine, sp = 0u;
    for (;;) {
        sum = 0u; cnt = 0u; mine = 0u;
#pragma unroll
        for (unsigned j = 0; j < 16; ++j) { const unsigned c = xb_ld(&bar[XB_XCNT(j)]); sum += c; cnt += (c > 0u) ? 1u : 0u; mine = (j == x) ? c : mine; }
        if (sum == G) break;
        __builtin_amdgcn_s_sleep(1);
        if ((++sp & 255u) == 0u) { if (xb_ld(&bar[XB_TMO])) break; if (sp > XB_SPIN_CAP) { atomicAdd(&bar[XB_TMO], 1u); break; } }
    }
    nloc = mine > 0u ? mine : 1u; nx = cnt > 0u ? cnt : 1u;
}

__device__ __forceinline__ void xcd_barrier(const XcdBarrier& b) {
    asm volatile("s_waitcnt vmcnt(0)" ::: "memory");
    __syncthreads();
    if (threadIdx.x == 0) {
        unsigned* bar = b.bar;
        __builtin_amdgcn_s_waitcnt(0);
        unsigned nloc = b.st[0], nx = b.st[1];
        if (nloc == 0u) { xcd_barrier_complete(bar, b.x, nloc, nx); b.st[0] = nloc; b.st[1] = nx; }
        const unsigned old = xb_add(&bar[XB_XSUB(b.x)], 1u);
        const unsigned gen = old / nloc;
        if (old + 1u == (gen + 1u) * nloc) {
            __builtin_amdgcn_fence(__ATOMIC_RELEASE, "agent");
            asm volatile("s_waitcnt vmcnt(0)" ::: "memory");
            const unsigned og = xb_add(&bar[XB_TOP], 1u);
            const unsigned tg = og / nx;
            if (og + 1u == (tg + 1u) * nx) xb_add(&bar[XB_TOPGEN], 1u);
            else XB_SPIN(xb_ld(&bar[XB_TOPGEN]) == tg, bar);
            __builtin_amdgcn_fence(__ATOMIC_ACQUIRE, "agent");
            xb_add(&bar[XB_XGEN(b.x)], 1u);
            asm volatile("s_waitcnt vmcnt(0)" ::: "memory");
        } else {
            XB_SPIN(xb_ld(&bar[XB_XGEN(b.x)]) == gen, bar);
            __builtin_amdgcn_fence(__ATOMIC_ACQUIRE, "agent");
            asm volatile("s_waitcnt vmcnt(0)" ::: "memory");
        }
    }
    __syncthreads();
}

struct Args { const float* in[19]; float* out; unsigned char* ws; int ph_lo, ph_hi; };
constexpr int N_PHASES = 8;

__global__ void __launch_bounds__(NTHREADS) mega_fwd(Args args) {
    extern __shared__ __attribute__((aligned(16))) unsigned char lds_raw[];
    LAS unsigned char* lds = (LAS unsigned char*)lds_raw;
    const int tid = threadIdx.x, lane = tid & 63, wave = __builtin_amdgcn_readfirstlane(tid >> 6);
    const int G = gridDim.x, bx = blockIdx.x;
    const int vcu = (G % 8 == 0) ? (bx % 8) * (G / 8) + bx / 8 : bx;
    const int gw = vcu * NWAVES + wave, NGW = G * NWAVES;
    unsigned char* ws = args.ws;
#define MAKE_P() Ptrs P; { unsigned char* w_ = args.ws; asm volatile("" : "+s"(w_)); \
    P.x = args.in[0]; P.norm1_g = args.in[1]; P.w_in = args.in[2]; P.q_norm_g = args.in[3]; P.k_norm_g = args.in[4]; P.lq1 = args.in[5]; P.lk1 = args.in[6]; P.lq2 = args.in[7]; P.lk2 = args.in[8]; \
    P.subln_g = args.in[9]; P.conv_w = args.in[10]; P.conv_b = args.in[11]; P.conv_ln_g = args.in[12]; P.conv_ln_b = args.in[13]; P.w_out = args.in[14]; P.norm2_g = args.in[15]; \
    P.w_gate = args.in[16]; P.w_up = args.in[17]; P.w_down = args.in[18]; P.out = args.out; \
    P.Wt_in = (bf16*)(w_ + WS_WIN); P.Wt_v = (bf16*)(w_ + WS_WV); P.Wt_out = (bf16*)(w_ + WS_WOUT); P.Wt_gu = (bf16*)(w_ + WS_WGU); P.Wt_dn = (bf16*)(w_ + WS_WDN); \
    P.XN = (bf16*)(w_ + WS_XN); P.Q = (bf16*)(w_ + WS_Q); P.K = (bf16*)(w_ + WS_K); P.VT = (bf16*)(w_ + WS_VT); P.U = (bf16*)(w_ + WS_U); P.MIX = (bf16*)(w_ + WS_MIX); P.ACT = (bf16*)(w_ + WS_ACT); \
    P.COS = (float*)(w_ + WS_COS); P.SIN = (float*)(w_ + WS_SIN); P.RSS = (float*)(w_ + WS_RSS); P.RS = (float*)(w_ + WS_RS); P.RS1 = (float*)(w_ + WS_RS1); }
    const int lo = args.ph_lo, hi = args.ph_hi;
    if (tid < 2) ((volatile LAS unsigned*)(lds + BARST_OFF))[tid] = 0u;
    __syncthreads();
    XcdBarrier gbar = xcd_barrier_post((unsigned*)(ws + WS_BAR), (volatile LAS unsigned*)(lds + BARST_OFF));
#ifndef PHASE_MASK
#define PHASE_MASK 0xff
#endif
#define IN(k) (((PHASE_MASK >> (k)) & 1) && lo <= (k) && (k) < hi)
#ifndef REP3
#define REP3 1
#endif
#ifndef REP6
#define REP6 1
#endif
#ifndef REP1
#define REP1 1
#endif
#define SEAM(k) do { if (IN(k) && IN((k) + 1)) { if (args.ph_hi > 1000) cooperative_groups::this_grid().sync(); else xcd_barrier(gbar); } } while (0)

    if (IN(0)) { MAKE_P(); p0_prologue(P, lds, gw, NGW, wave, lane); }
    SEAM(0);
    if (IN(1)) {
        MAKE_P();
        { pg8::Gemm g{P.XN, P.Wt_in, M_TOK, 4096, DM}; pg8::OrderRs S; S.init(M_TOK, 4096, G, bx); S.rsv = P.RS1; S.wr_ = wave >> 2; S.lane_ = lane; S.a0 = S.a1 = S.b0 = S.b1 = 0.f; S.n_ready = 0;
          pg8::EpiProjP E{P.Q, P.K, P.U, &S, 0};
          pg8::gemm_phase<pg8::EpiProjP, pg8::OrderRs, true, true>(lds, g, S, E); }
        { pg8::Gemm g{P.Wt_v, P.XN, 1024, M_TOK, DM}; pg8::StaticOrder S; S.init(1024, M_TOK, G, bx); pg8::EpiPlainC E{P.VT, M_TOK, P.RS1};
          pg8::gemm_phase<pg8::EpiPlainC, pg8::StaticOrder, true, true>(lds, g, S, E); }
    }
    SEAM(1);
    if (IN(2)) { MAKE_P(); p2_qk_norm_rope(P, gw, NGW, lane); }
    SEAM(2);
    if (IN(3)) {
        MAKE_P();
#ifndef NO_CONV
        p3_conv(P, lds, bx, G, tid, wave, lane);
#endif
        float lam, negMb;
        { const float a = P.lq1[lane] * P.lk1[lane] + P.lq1[lane + 64] * P.lk1[lane + 64], c = P.lq2[lane] * P.lk2[lane] + P.lq2[lane + 64] * P.lk2[lane + 64];
          lam = expf(wave_sum(a)) - expf(wave_sum(c)) + LAMBDA_INIT;
          const float gq = wave_max(fmaxf(fabsf(P.q_norm_g[lane]), fabsf(P.q_norm_g[lane + 64]))), gk = wave_max(fmaxf(fabsf(P.k_norm_g[lane]), fabsf(P.k_norm_g[lane + 64])));
          negMb = -(gq * gk * 11.313708498984761f * 1.4426950408889634f * 1.01f);
          lam = __builtin_bit_cast(float, __builtin_amdgcn_readfirstlane(__builtin_bit_cast(int, lam))); negMb = __builtin_bit_cast(float, __builtin_amdgcn_readfirstlane(__builtin_bit_cast(int, negMb))); }
#ifndef NO_ATT
        if (tid < 64) *(LAS f32x4*)(lds + MISC_OFF + 3072 + tid * 16) = *(const f32x4*)(P.subln_g + tid * 4);
        __syncthreads();
        for (int item = vcu; item < 512; item += G) {
            const int bh = item >> 5, pair = item & 31;
            for (int half = 0; half < 2 * REP3; ++half)
                att::attn_block(lds, P, bh >> 2, bh & 3, (half & 1) ? pair : 63 - pair, negMb, lam, tid, wave, lane);
        }
#endif
    }
    SEAM(3);
    if (IN(4)) { MAKE_P(); pg8::Gemm g{P.MIX, P.Wt_out, M_TOK, DM, DM}; pg8::StaticOrder S; S.init(M_TOK, DM, G, bx); pg8::EpiResNorm3 E{P.XN, P.RSS, DM, (LAS float*)(lds + MISC_OFF)};
        pg8::gemm_phase<pg8::EpiResNorm3, pg8::StaticOrder, true, true>(lds, g, S, E); }
    SEAM(4);
    if (IN(5)) { MAKE_P(); const int i = (vcu * NWAVES + wave) * 64 + lane;
        if (i < M_TOK) { const f32x4 p0 = *(const f32x4*)(P.RSS + (size_t)i * 8), p1 = *(const f32x4*)(P.RSS + (size_t)i * 8 + 4);
            P.RS[i] = 1.0f / sqrtf((((p0[0] + p0[1]) + (p0[2] + p0[3])) + ((p1[0] + p1[1]) + (p1[2] + p1[3]))) * (1.0f / DM) + EPS_RMS); } }
    SEAM(5);
    if (IN(6)) { MAKE_P(); pg8::Gemm g{P.XN, P.Wt_gu, M_TOK, 2 * FFN, DM}; pg8::OrderRs S; S.init(M_TOK, 2 * FFN, G, bx); S.rsv = P.RS; S.wr_ = wave >> 2; S.lane_ = lane; S.a0 = S.a1 = S.b0 = S.b1 = 0.f; S.n_ready = 0; pg8::EpiSwiGLUP E{P.ACT, FFN, &S, 0};
        pg8::gemm_phase<pg8::EpiSwiGLUP, pg8::OrderRs, true, true>(lds, g, S, E); }
    SEAM(6);
    if (IN(7)) { MAKE_P(); pg8::Gemm g{P.ACT, P.Wt_dn, M_TOK, DM, FFN}; pg8::StaticOrder S; S.init(M_TOK, DM, G, bx); pg8::EpiResB E{P.XN, P.out, DM};
        pg8::gemm_phase<pg8::EpiResB, pg8::StaticOrder, true, true>(lds, g, S, E); }
#undef IN
#undef SEAM
}

#ifndef MK_MULTI
#define MK_MULTI 0
#endif
extern "C" void kernel_launch(void* const* d_in, const int* in_sizes, int n_in, void* d_out, int out_size, void* d_ws, size_t ws_size, hipStream_t stream) {
    static int grid = 0;
    if (grid == 0) {
        if (n_in != 19 || ws_size < WS_END) { fprintf(stderr, "kernel_launch: unexpected n_in %d / ws %zu\n", n_in, ws_size); grid = -1; return; }
        int dev = 0, cus = 0, per_cu = 0;
        hipGetDevice(&dev); hipDeviceGetAttribute(&cus, hipDeviceAttributeMultiprocessorCount, dev);
        if (hipFuncSetAttribute((const void*)mega_fwd, hipFuncAttributeMaxDynamicSharedMemorySize, LDS_BYTES) != hipSuccess) { fprintf(stderr, "kernel_launch: hipFuncSetAttribute failed\n"); }
        if (hipOccupancyMaxActiveBlocksPerMultiprocessor(&per_cu, (const void*)mega_fwd, NTHREADS, LDS_BYTES) != hipSuccess || per_cu < 1) { fprintf(stderr, "kernel_launch: occupancy query says %d\n", per_cu); per_cu = 1; }
        (void)hipGetLastError();
        grid = cus * per_cu;
        fprintf(stderr, "kernel_launch: grid %d (cus %d x %d)\n", grid, cus, per_cu);
    }
    if (grid < 0) return;
    if (hipMemsetAsync((char*)d_ws + WS_BAR, 0, BAR_ZERO_BYTES, stream) != hipSuccess) { fprintf(stderr, "kernel_launch: hipMemsetAsync failed\n"); return; }
    Args a{};
    for (int i = 0; i < 19; ++i) a.in[i] = (const float*)d_in[i];
    a.out = (float*)d_out; a.ws = (unsigned char*)d_ws;
#if MK_MULTI
    for (int ph = 0; ph < N_PHASES; ++ph) { a.ph_lo = ph; a.ph_hi = ph + 1; hipLaunchKernelGGL(mega_fwd, dim3(grid), dim3(NTHREADS), LDS_BYTES, stream, a); }
#else
    a.ph_lo = 0; a.ph_hi = N_PHASES;
    void* kargs[] = {(void*)&a};
    hipError_t e = hipLaunchCooperativeKernel((const void*)mega_fwd, dim3(grid), dim3(NTHREADS), kargs, LDS_BYTES, stream);
    if (e != hipSuccess) fprintf(stderr, "kernel_launch: cooperative launch failed: %s (grid %d)\n", hipGetErrorString(e), grid);
#endif
}
```
